# Optimizing an MI355X kernel written in HIP

```python
import math
import jax, jax.numpy as jnp
from jax import lax
import numpy as np

D_MODEL = 1024
BATCH = 16
SEQ = 2048
DEPTH = 4

N_Q_HEADS = 8
N_KV_HEADS = 2
HEAD_DIM = 64
ATTN_WIDTH = N_Q_HEADS * HEAD_DIM
KV_WIDTH = N_KV_HEADS * HEAD_DIM
WINDOW = 128
ATTN_BLOCK = 128
GMLP_GROUPS = 4
GMLP_GROUP_DIM = 128
GMLP_WIDTH = GMLP_GROUPS * GMLP_GROUP_DIM
CHUNK = 128
SPLITS = (ATTN_WIDTH, KV_WIDTH, KV_WIDTH, ATTN_WIDTH,
          GMLP_WIDTH, GMLP_WIDTH, GMLP_WIDTH, D_MODEL, D_MODEL)
IN_WIDTH = sum(SPLITS)
ALPHA = (2 * DEPTH) ** 0.25
BETA = (8 * DEPTH) ** -0.25
LN_EPS = 1e-5

kernel_name = "hybrid_swa_sink_gmlp_deepnorm"


def layer_norm(x, g, b):
    xf = x.astype(jnp.float32)
    mu = xf.mean(-1, keepdims=True)
    var = jnp.square(xf - mu).mean(-1, keepdims=True)
    y = (xf - mu) * lax.rsqrt(var + LN_EPS)
    return (y * g.astype(jnp.float32) + b.astype(jnp.float32)).astype(x.dtype)


def alibi_slopes():
    h = jnp.arange(N_Q_HEADS, dtype=jnp.float32)
    return jnp.exp2(-8.0 * (h + 1.0) / N_Q_HEADS)


def split_columns(h):
    offs = [int(o) for o in np.cumsum(SPLITS)[:-1]]
    return jnp.split(h, offs, axis=-1)


def sliding_window_attention(q, k, v, sinks):
    B, S = q.shape[0], q.shape[1]
    nb = S // ATTN_BLOCK
    grp = N_Q_HEADS // N_KV_HEADS
    qb = q.reshape(B, nb, ATTN_BLOCK, N_KV_HEADS, grp, HEAD_DIM)

    def band(t):
        tb = t.reshape(B, nb, ATTN_BLOCK, N_KV_HEADS, HEAD_DIM)
        prev = jnp.pad(tb, ((0, 0), (1, 0), (0, 0), (0, 0), (0, 0)))[:, :-1]
        return jnp.concatenate([prev, tb], axis=2)

    kb, vb = band(k), band(v)
    scores = jnp.einsum('bnqhgd,bnkhd->bnhgqk', qb, kb).astype(jnp.float32) * (HEAD_DIM ** -0.5)
    qi = jnp.arange(ATTN_BLOCK)[:, None]
    kj = jnp.arange(2 * ATTN_BLOCK)[None, :]
    dist = qi + ATTN_BLOCK - kj
    blk = jnp.arange(nb)[:, None, None]
    key_pos = blk * ATTN_BLOCK + qi - dist
    valid = (dist >= 0) & (dist < WINDOW) & (key_pos >= 0)
    slopes = alibi_slopes().reshape(N_KV_HEADS, grp)
    scores = scores - slopes[:, :, None, None] * dist.astype(jnp.float32)
    scores = jnp.where(valid[None, :, None, None], scores, -jnp.inf)
    sink = sinks.astype(jnp.float32).reshape(N_KV_HEADS, grp)[None, None, :, :, None, None]
    m = jnp.maximum(scores.max(-1, keepdims=True), sink)
    p = jnp.exp(scores - m)
    denom = p.sum(-1, keepdims=True) + jnp.exp(sink - m)
    out = jnp.einsum('bnhgqk,bnkhd->bnqhgd', (p / denom).astype(v.dtype), vb)
    return out.reshape(B, S, ATTN_WIDTH)


def chunked_spatial_gating(u, v, ln_g, ln_b, w_s, b_s):
    B, S = v.shape[0], v.shape[1]
    nc = S // CHUNK
    vn = layer_norm(v, ln_g, ln_b).reshape(B, nc, CHUNK, GMLP_GROUPS, GMLP_GROUP_DIM)
    causal = jnp.tril(jnp.ones((CHUNK, CHUNK), dtype=bool))
    w = jnp.where(causal[None], w_s, jnp.zeros_like(w_s))
    mixed = jnp.einsum('gts,bcsgd->bctgd', w, vn) + b_s.T[None, None, :, :, None]
    return u * mixed.reshape(B, S, GMLP_WIDTH)


def setup_inputs(seed: int = 0) -> dict:
    key = jax.random.key(seed)
    ks = jax.random.split(key, 16)
    f32 = jnp.float32
    x = jax.random.normal(ks[0], (BATCH, SEQ, D_MODEL), f32)
    w_in = jax.random.normal(ks[1], (DEPTH, D_MODEL, IN_WIDTH), f32) * D_MODEL ** -0.5
    b_in = jax.random.normal(ks[2], (DEPTH, IN_WIDTH), f32) * 0.02
    attn_sinks = jax.random.normal(ks[3], (DEPTH, N_Q_HEADS), f32) * 0.5
    gmlp_ln_g = 1.0 + 0.02 * jax.random.normal(ks[4], (DEPTH, GMLP_WIDTH), f32)
    gmlp_ln_b = 0.02 * jax.random.normal(ks[5], (DEPTH, GMLP_WIDTH), f32)
    w_spatial = jax.random.normal(ks[6], (DEPTH, GMLP_GROUPS, CHUNK, CHUNK), f32) * (0.5 * CHUNK ** -0.5)
    b_spatial = 1.0 + 0.02 * jax.random.normal(ks[7], (DEPTH, GMLP_GROUPS, CHUNK), f32)
    w_branch_attn = jax.random.normal(ks[8], (DEPTH, ATTN_WIDTH, D_MODEL), f32) * (ATTN_WIDTH ** -0.5 * BETA)
    w_branch_gmlp = jax.random.normal(ks[9], (DEPTH, GMLP_WIDTH, D_MODEL), f32) * (GMLP_WIDTH ** -0.5 * BETA)
    w_out = jax.random.normal(ks[10], (DEPTH, D_MODEL, D_MODEL), f32) * (D_MODEL ** -0.5 * BETA)
    b_out = 0.02 * jax.random.normal(ks[11], (DEPTH, D_MODEL), f32)
    ln_g = 1.0 + 0.02 * jax.random.normal(ks[12], (DEPTH, D_MODEL), f32)
    ln_b = 0.02 * jax.random.normal(ks[13], (DEPTH, D_MODEL), f32)
    return {"x": x, "w_in": w_in, "b_in": b_in, "attn_sinks": attn_sinks,
            "gmlp_ln_g": gmlp_ln_g, "gmlp_ln_b": gmlp_ln_b,
            "w_spatial": w_spatial, "b_spatial": b_spatial,
            "w_branch_attn": w_branch_attn, "w_branch_gmlp": w_branch_gmlp,
            "w_out": w_out, "b_out": b_out, "ln_g": ln_g, "ln_b": ln_b}


def reference(x, w_in, b_in, attn_sinks, gmlp_ln_g, gmlp_ln_b, w_spatial, b_spatial,
              w_branch_attn, w_branch_gmlp, w_out, b_out, ln_g, ln_b):
    B, S = x.shape[0], x.shape[1]
    for l in range(DEPTH):
        h = jnp.einsum('bsd,de->bse', x, w_in[l]) + b_in[l]
        q, k, v, z_a, u_g, v_g, z_g, g_a, g_g = split_columns(h)
        y_a = sliding_window_attention(q.reshape(B, S, N_Q_HEADS, HEAD_DIM),
                                       k.reshape(B, S, N_KV_HEADS, HEAD_DIM),
                                       v.reshape(B, S, N_KV_HEADS, HEAD_DIM),
                                       attn_sinks[l]) * jax.nn.silu(z_a)
        y_g = chunked_spatial_gating(jax.nn.gelu(u_g, approximate=False),
                                     jax.nn.gelu(v_g, approximate=False),
                                     gmlp_ln_g[l], gmlp_ln_b[l],
                                     w_spatial[l], b_spatial[l]) * jax.nn.silu(z_g)
        br_a = jnp.einsum('bse,ed->bsd', y_a, w_branch_attn[l])
        br_g = jnp.einsum('bse,ed->bsd', y_g, w_branch_gmlp[l])
        merged = jax.nn.sigmoid(g_a) * br_a + jax.nn.sigmoid(g_g) * br_g
        out = jnp.einsum('bsd,de->bse', merged, w_out[l]) + b_out[l]
        x = layer_norm(ALPHA * x + out, ln_g[l], ln_b[l])
    return x
```

```cpp
#include <hip/hip_runtime.h>
#include <hip/hip_cooperative_groups.h>
#include <cstdio>
#include <cstdint>
namespace cg = cooperative_groups;

#define LAS __attribute__((address_space(3)))
typedef unsigned short bf16_t;
typedef short bf16x8 __attribute__((ext_vector_type(8)));
typedef short s16x4 __attribute__((ext_vector_type(4)));
typedef float f32x4 __attribute__((ext_vector_type(4)));
typedef float f32x2 __attribute__((ext_vector_type(2)));
typedef unsigned u32x4 __attribute__((ext_vector_type(4)));
typedef unsigned u32x2 __attribute__((ext_vector_type(2)));

constexpr int MROWS = 32768, DM = 1024, NIN = 4864, DEPTH = 4;
constexpr int C_Q = 0, C_K = 512, C_V = 640, C_ZA = 768, C_U = 1280, C_VG = 1792, C_ZG = 2304, C_GA = 2816, C_GG = 3840;
constexpr float ALPHA = 1.6817928305074290f;
constexpr float LN_EPS = 1e-5f;
constexpr size_t MiB = 1u << 20;
constexpr size_t WS_WIN = 0, WS_WBR = 38 * MiB, WS_WOUT = 46 * MiB, WS_WSP = 54 * MiB, WS_CTL = 55 * MiB, WS_XB = 56 * MiB, WS_Y = 120 * MiB, WS_H = 184 * MiB, WS_END = 488 * MiB;
constexpr int LDS_BYTES = 147456;

typedef __bf16 bf16x2_t __attribute__((ext_vector_type(2)));
__device__ __forceinline__ unsigned cvt_pk_bf16(float lo, float hi) { const f32x2 v = (f32x2){lo, hi}; const bf16x2_t r = __builtin_convertvector(v, bf16x2_t); return __builtin_bit_cast(unsigned, r); }
__device__ __forceinline__ float bf_lo(unsigned w) { return __uint_as_float(w << 16); }
__device__ __forceinline__ float bf_hi(unsigned w) { return __uint_as_float(w & 0xffff0000u); }
__device__ __forceinline__ float shx(float v, int o, int lane) { return __int_as_float(__builtin_amdgcn_ds_bpermute((lane ^ o) << 2, __float_as_int(v))); }
__device__ __forceinline__ float wave_sum(float v, int lane) {
#pragma unroll
    for (int o = 1; o < 64; o <<= 1) v += shx(v, o, lane);
    return v;
}
__device__ __forceinline__ float sigmoidf_(float v) { return __builtin_amdgcn_rcpf(1.0f + __expf(-v)); }
__device__ __forceinline__ f32x2 gelu_pk(f32x2 v) {
    const f32x2 av = __builtin_elementwise_abs(v), d = av * 0.2316418882f + 1.0f;
    f32x2 t; t.x = __builtin_amdgcn_rcpf(d.x); t.y = __builtin_amdgcn_rcpf(d.y);
    f32x2 q = t * 0.5307027145f + (-0.7265760135f); q = q * t + 0.7107068705f; q = q * t + (-0.142248368f); q = q * t + 0.127414796f; q = q * t;
    const f32x2 s = (v * v) * (-0.72134752044f);
    f32x2 e; e.x = __builtin_amdgcn_exp2f(s.x); e.y = __builtin_amdgcn_exp2f(s.y);
    const f32x2 m = v * (q * e), r = v - m;
    f32x2 o; o.x = v.x < 0.f ? m.x : r.x; o.y = v.y < 0.f ? m.y : r.y; return o;
}
template <int ACT> __device__ __forceinline__ f32x4 act4(f32x4 v) {
    if constexpr (ACT == 1) { f32x4 o; for (int j = 0; j < 4; ++j) o[j] = v[j] * sigmoidf_(v[j]); return o; }
    else if constexpr (ACT == 2) { const f32x2 a = gelu_pk((f32x2){v[0], v[1]}), b = gelu_pk((f32x2){v[2], v[3]}); return (f32x4){a.x, a.y, b.x, b.y}; }
    else if constexpr (ACT == 3) { f32x4 o; for (int j = 0; j < 4; ++j) o[j] = sigmoidf_(v[j]); return o; }
    else return v;
}

namespace pg8 {
constexpr int BM = 256, BK = 64, HALF = 128, HTB = HALF * BK * 2, NXCD = 8, WGM = 8;
__host__ __device__ __forceinline__ int lds_byte(int r, int c) { const int st = (r >> 4) * 2 + (c >> 5), rr = r & 15, cc = c & 31, ob = rr * 64 + cc * 2; return st * 1024 + (ob ^ (((ob >> 9) & 1) << 5)); }
__host__ __device__ __forceinline__ void stage_rc(int b, int& R, int& C) { const int st = b / 1024, sb = b % 1024, swz = sb ^ (((sb >> 9) & 1) << 5); R = (st >> 1) * 16 + swz / 64; C = (st & 1) * 32 + (swz % 64) / 2; }
__host__ __device__ __forceinline__ int perm32(int rho) { const int n = rho >> 4, i = rho & 15; return 8 * (i >> 2) + 4 * n + (i & 3); }

struct Unit { int pm, pn, kh; };
struct Gemm { const bf16_t* A; const bf16_t* Bt; int K, lda, ldb; };

struct Order {
    int nM, nN, nwg, G, c, halves;
    __device__ void init(int M, int N, int G_, int c_, int halves_) { nM = M / BM; nN = N / BM; nwg = nM * nN; G = G_; c = c_; halves = halves_; }
    __device__ bool next(int i, Unit& u) const {
        const int ti = (halves == 2) ? (i >> 1) : i; u.kh = (halves == 2) ? (i & 1) : 0;
        const long L = (long)ti * G + c; if (L >= nwg) return false;
        int wgid = (int)L; { const int q = nwg / NXCD, r = nwg % NXCD, xcd = wgid % NXCD, off = wgid / NXCD; wgid = (xcd < r ? xcd * (q + 1) : r * (q + 1) + (xcd - r) * q) + off; }
        const int nig = WGM * nN, gid = wgid / nig, fm = gid * WGM, gsz = (nM - fm) < WGM ? (nM - fm) : WGM;
        u.pm = fm + ((wgid % nig) % gsz); u.pn = (wgid % nig) / gsz; return true;
    }
};

typedef f32x4 Acc[2][2][4][2];

struct EpiH {
    static constexpr bool PERM = true;
    bf16_t* H; const float* bias;
    __device__ __forceinline__ bool keep(const Unit&) const { return false; }
    template <int ACT> __device__ __forceinline__ void body(const Acc& acc, const Unit& u, int wr, int wc, int fr, int fq) const {
        const int row0 = u.pm * BM + wr * 64 + fr, col0 = u.pn * BM + wc * 32 + 8 * fq;
#pragma unroll
        for (int bj = 0; bj < 2; ++bj) {
            const f32x4 bv0 = *(const f32x4*)(bias + col0 + bj * HALF), bv1 = *(const f32x4*)(bias + col0 + bj * HALF + 4);
#pragma unroll
            for (int ai = 0; ai < 2; ++ai)
#pragma unroll
                for (int m = 0; m < 4; ++m) { bf16_t* rowp = H + (size_t)(row0 + ai * HALF + m * 16) * NIN + col0 + bj * HALF;
                    const f32x4 v0 = act4<ACT>(acc[ai][bj][m][0] + bv0), v1 = act4<ACT>(acc[ai][bj][m][1] + bv1);
                    u32x4 w; w.x = cvt_pk_bf16(v0[0], v0[1]); w.y = cvt_pk_bf16(v0[2], v0[3]); w.z = cvt_pk_bf16(v1[0], v1[1]); w.w = cvt_pk_bf16(v1[2], v1[3]);
                    *(u32x4*)rowp = w; }
        }
    }
    __device__ __forceinline__ void operator()(Acc& acc, const Unit& u, int wr, int wc, int fr, int fq) const {
        const int pn = u.pn;
        if (pn < 3) body<0>(acc, u, wr, wc, fr, fq);
        else if (pn < 5 || (pn >= 9 && pn < 11)) body<1>(acc, u, wr, wc, fr, fq);
        else if (pn < 9) body<2>(acc, u, wr, wc, fr, fq);
        else body<3>(acc, u, wr, wc, fr, fq);
    }
};
struct EpiMerge {
    static constexpr bool PERM = true;
    bf16_t* H;
    __device__ __forceinline__ bool keep(const Unit& u) const { return u.kh == 0; }
    __device__ __forceinline__ void operator()(Acc& acc, const Unit& u, int wr, int wc, int fr, int fq) const {
        const int row0 = u.pm * BM + wr * 64 + fr, col0 = u.pn * BM + wc * 32 + 8 * fq;
#pragma unroll
        for (int ai = 0; ai < 2; ++ai)
#pragma unroll
            for (int m = 0; m < 4; ++m) { bf16_t* rowp = H + (size_t)(row0 + ai * HALF + m * 16) * NIN + col0;
#pragma unroll
                for (int bj = 0; bj < 2; ++bj) {
                    const u32x4 g = *(const u32x4*)(rowp + C_GG + bj * HALF);
                    const f32x4 sg0 = (f32x4){bf_lo(g.x), bf_hi(g.x), bf_lo(g.y), bf_hi(g.y)}, sg1 = (f32x4){bf_lo(g.z), bf_hi(g.z), bf_lo(g.w), bf_hi(g.w)};
                    if (u.kh == 0) {
                        const u32x4 a = *(const u32x4*)(rowp + C_GA + bj * HALF);
                        const f32x4 sa0 = (f32x4){bf_lo(a.x), bf_hi(a.x), bf_lo(a.y), bf_hi(a.y)}, sa1 = (f32x4){bf_lo(a.z), bf_hi(a.z), bf_lo(a.w), bf_hi(a.w)};
#pragma unroll
                        for (int j = 0; j < 4; ++j) { acc[ai][bj][m][0][j] *= sa0[j] * __builtin_amdgcn_rcpf(sg0[j]); acc[ai][bj][m][1][j] *= sa1[j] * __builtin_amdgcn_rcpf(sg1[j]); }
                    } else {
                        const f32x4 v0 = acc[ai][bj][m][0] * sg0, v1 = acc[ai][bj][m][1] * sg1;
                        u32x4 w; w.x = cvt_pk_bf16(v0[0], v0[1]); w.y = cvt_pk_bf16(v0[2], v0[3]); w.z = cvt_pk_bf16(v1[0], v1[1]); w.w = cvt_pk_bf16(v1[2], v1[3]);
                        *(u32x4*)(rowp + bj * HALF) = w;
                    } }
                asm volatile("" ::: "memory"); }
    }
};
struct EpiRes {
    static constexpr bool PERM = false;
    const float* xin; float* R; const float* bias;
    __device__ __forceinline__ bool keep(const Unit&) const { return false; }
    __device__ __forceinline__ void operator()(Acc& acc, const Unit& u, int wr, int wc, int fr, int fq) const {
        const int row0 = u.pm * BM + wr * 64 + fr, col0 = u.pn * BM + wc * 32 + 4 * fq;
        f32x4 bv[2][2];
#pragma unroll
        for (int bj = 0; bj < 2; ++bj)
#pragma unroll
            for (int n = 0; n < 2; ++n) bv[bj][n] = *(const f32x4*)(bias + col0 + bj * HALF + n * 16);
#pragma unroll
        for (int ai = 0; ai < 2; ++ai)
#pragma unroll
            for (int m = 0; m < 4; ++m) { const size_t off = (size_t)(row0 + ai * HALF + m * 16) * DM + col0;
#pragma unroll
                for (int bj = 0; bj < 2; ++bj)
#pragma unroll
                    for (int n = 0; n < 2; ++n) { const f32x4 xv = *(const f32x4*)(xin + off + bj * HALF + n * 16);
                        *(f32x4*)(R + off + bj * HALF + n * 16) = xv * ALPHA + acc[ai][bj][m][n] + bv[bj][n]; }
                asm volatile("" ::: "memory"); }
    }
};

template <class Epi>
__device__ __forceinline__ void gemm_phase(LAS unsigned char* lds, const Gemm g, const Order& S, const Epi& E) {
    int tid_ = threadIdx.x; asm volatile("" : "+v"(tid_));
    const int tid = tid_, wid = __builtin_amdgcn_readfirstlane(tid >> 6), lane = tid & 63, wr = wid >> 2, wc = wid & 3, fr = lane & 15, fq = lane >> 4;
    const int K = g.K, nt = K / BK;
    unsigned voffA[2], voffB[2];
#pragma unroll
    for (int i = 0; i < 2; ++i) { int R, C; stage_rc(tid * 16 + i * 8192, R, C); const int Rb = Epi::PERM ? ((R & ~31) + perm32(R & 31)) : R;
        voffA[i] = (unsigned)(R * g.lda + C) * 2u; voffB[i] = (unsigned)(Rb * g.ldb + C) * 2u; }
    const size_t kstep = (size_t)(BK * 2);
    const size_t hstepA = (size_t)HALF * g.lda * 2, hstepB = (size_t)HALF * g.ldb * 2;
    const size_t tstepA = 2 * hstepA, tstepB = 2 * hstepB, khstep = (size_t)K * 2;
    const unsigned ldsw = (unsigned)wid * 1024u;
    const int aoff = lds_byte(wr * 64 + fr, fq * 8), boff = lds_byte(wc * 32 + fr, fq * 8);
#define PG8_SA(b, h) (((b) * 2 + (h)) * HTB)
#define PG8_SB(b, h) ((4 + (b) * 2 + (h)) * HTB)
#define PG8_STAGE(bufoff, gbase, voff) do { _Pragma("unroll") for (int _i = 0; _i < 2; ++_i) \
        __builtin_amdgcn_global_load_lds((const unsigned*)((const char*)(gbase) + (voff)[_i]), (LAS unsigned*)(lds + (bufoff) + ldsw + _i * 8192), 16, 0, 0); } while (0)
#define PG8_LDA(dst, b, h) do { _Pragma("unroll") for (int m = 0; m < 4; ++m) _Pragma("unroll") for (int k = 0; k < 2; ++k) dst[m][k] = *(const LAS bf16x8*)(lds + PG8_SA(b, h) + aoff + m * 2048 + k * 1024); } while (0)
#define PG8_LDB(dst, b, h) do { _Pragma("unroll") for (int n = 0; n < 2; ++n) _Pragma("unroll") for (int k = 0; k < 2; ++k) dst[n][k] = *(const LAS bf16x8*)(lds + PG8_SB(b, h) + boff + n * 2048 + k * 1024); } while (0)
#define PG8_MMA(ai, bj, At, Bt) do { __builtin_amdgcn_s_setprio(1); _Pragma("unroll") for (int m = 0; m < 4; ++m) _Pragma("unroll") for (int n = 0; n < 2; ++n) _Pragma("unroll") for (int k = 0; k < 2; ++k) \
        acc[ai][bj][m][n] = __builtin_amdgcn_mfma_f32_16x16x32_bf16(Bt[n][k], At[m][k], acc[ai][bj][m][n], 0, 0, 0); __builtin_amdgcn_s_setprio(0); } while (0)
#define PG8_WAIT_V(n) asm volatile("s_waitcnt vmcnt(" #n ")" ::: "memory")
#define PG8_WAIT_L(n) asm volatile("s_waitcnt lgkmcnt(" #n ")" ::: "memory")
#define PG8_BAR __builtin_amdgcn_s_barrier()
#define PG8_SCHED __builtin_amdgcn_sched_barrier(0)
    Unit cur, nxt; int ui = 0;
    if (!S.next(0, cur)) return;
    Acc acc;
#pragma unroll
    for (int a = 0; a < 2; ++a)
#pragma unroll
        for (int b = 0; b < 2; ++b)
#pragma unroll
            for (int m = 0; m < 4; ++m)
#pragma unroll
                for (int n = 0; n < 2; ++n) acc[a][b][m][n] = (f32x4){0.f, 0.f, 0.f, 0.f};
    bf16x8 At[4][2], B0[2][2], B1[2][2];
    const char* cA = (const char*)g.A + (size_t)cur.pm * tstepA + (size_t)cur.kh * khstep; const char* cB = (const char*)g.Bt + (size_t)cur.pn * tstepB + (size_t)cur.kh * khstep;
    PG8_STAGE(PG8_SB(0, 0), cB, voffB); PG8_STAGE(PG8_SB(0, 1), cB + hstepB, voffB); PG8_STAGE(PG8_SA(0, 0), cA, voffA); PG8_STAGE(PG8_SA(0, 1), cA + hstepA, voffA);
    if (wr == 1) PG8_BAR;
    PG8_WAIT_V(2); PG8_BAR;
    PG8_STAGE(PG8_SB(1, 0), cB + kstep, voffB); PG8_STAGE(PG8_SA(1, 0), cA + kstep, voffA); PG8_STAGE(PG8_SB(1, 1), cB + hstepB + kstep, voffB);
    PG8_WAIT_V(6); PG8_BAR;
    for (;;) {
        const bool has_next = S.next(ui + 1, nxt);
        const char* nA = has_next ? (const char*)g.A + (size_t)nxt.pm * tstepA + (size_t)nxt.kh * khstep : cA;
        const char* nB = has_next ? (const char*)g.Bt + (size_t)nxt.pn * tstepB + (size_t)nxt.kh * khstep : cB;
        for (int t = 0; t < nt; t += 2) {
            const bool last = (t == nt - 2);
            const char* a1 = cA + (size_t)(t + 1) * kstep;
            const char* a2 = last ? nA : cA + (size_t)(t + 2) * kstep; const char* b2 = last ? nB : cB + (size_t)(t + 2) * kstep;
            const char* a3 = a2 + kstep; const char* b3 = b2 + kstep;
            PG8_LDB(B0, 0, 0); PG8_LDB(B1, 0, 1); PG8_SCHED; PG8_LDA(At, 0, 0); PG8_STAGE(PG8_SA(1, 1), a1 + hstepA, voffA);
            PG8_WAIT_V(8); PG8_WAIT_L(0); PG8_BAR; PG8_MMA(0, 0, At, B0); PG8_MMA(0, 1, At, B1); PG8_BAR; PG8_SCHED;
            PG8_LDA(At, 0, 1); PG8_STAGE(PG8_SB(0, 0), b2, voffB); PG8_STAGE(PG8_SB(0, 1), b2 + hstepB, voffB); PG8_STAGE(PG8_SA(0, 0), a2, voffA);
            PG8_WAIT_V(8); PG8_WAIT_L(0); PG8_BAR; PG8_MMA(1, 0, At, B0); PG8_MMA(1, 1, At, B1); PG8_BAR; PG8_SCHED;
            PG8_LDB(B0, 1, 0); PG8_LDB(B1, 1, 1); PG8_SCHED; PG8_LDA(At, 1, 0); PG8_STAGE(PG8_SA(0, 1), a2 + hstepA, voffA);
            PG8_WAIT_V(8); PG8_WAIT_L(0); PG8_BAR; PG8_MMA(0, 0, At, B0); PG8_MMA(0, 1, At, B1); PG8_BAR; PG8_SCHED;
            PG8_LDA(At, 1, 1); PG8_STAGE(PG8_SB(1, 0), b3, voffB); PG8_STAGE(PG8_SB(1, 1), b3 + hstepB, voffB); PG8_STAGE(PG8_SA(1, 0), a3, voffA);
            PG8_WAIT_V(8); PG8_WAIT_L(0); PG8_BAR; PG8_MMA(1, 0, At, B0); PG8_MMA(1, 1, At, B1); PG8_BAR; PG8_SCHED;
        }
        if (wr == 0) PG8_BAR;
        E(acc, cur, wr, wc, fr, fq);
        if (!has_next) break;
        if (!E.keep(cur)) {
#pragma unroll
            for (int a = 0; a < 2; ++a)
#pragma unroll
                for (int b = 0; b < 2; ++b)
#pragma unroll
                    for (int m = 0; m < 4; ++m)
#pragma unroll
                        for (int n = 0; n < 2; ++n) acc[a][b][m][n] = (f32x4){0.f, 0.f, 0.f, 0.f};
        }
        cur = nxt; cA = nA; cB = nB; ++ui;
        if (wr == 1) PG8_BAR;
    }
    PG8_WAIT_V(0);
    PG8_BAR;
#undef PG8_SA
#undef PG8_SB
#undef PG8_STAGE
#undef PG8_LDA
#undef PG8_LDB
#undef PG8_MMA
#undef PG8_WAIT_V
#undef PG8_WAIT_L
#undef PG8_BAR
#undef PG8_SCHED
}
}

#define MFMA16(a, b, c) __builtin_amdgcn_mfma_f32_16x16x32_bf16((a), (b), (c), 0, 0, 0)

__device__ __forceinline__ unsigned f2bf(float f) { unsigned u = __float_as_uint(f); return (u + 0x7fffu + ((u >> 16) & 1u)) >> 16; }
__device__ __forceinline__ unsigned pk2(float lo, float hi) { return f2bf(lo) | (f2bf(hi) << 16); }
__device__ __forceinline__ void transpose_item(const float* W, int N, bf16_t* WT, int ldo, int col_off, LAS float* scr, int item, int lane) {
    const int nblk = N / 32, kb = item / nblk, nb = item % nblk, k0 = 64 * kb, n0 = 32 * nb;
#pragma unroll 8
    for (int i = 0; i < 32; ++i) { const int kk = 2 * i + (lane >> 5); scr[kk * 33 + (lane & 31)] = W[(size_t)(k0 + kk) * N + n0 + (lane & 31)]; }
    asm volatile("s_waitcnt lgkmcnt(0)" ::: "memory");
    const int c = lane & 7;
#pragma unroll
    for (int j = 0; j < 4; ++j) { const int n = (lane >> 3) + 8 * j; const LAS float* s = scr + (8 * c) * 33 + n;
        u32x4 o; o.x = pk2(s[0 * 33], s[1 * 33]); o.y = pk2(s[2 * 33], s[3 * 33]); o.z = pk2(s[4 * 33], s[5 * 33]); o.w = pk2(s[6 * 33], s[7 * 33]);
        *(u32x4*)(WT + (size_t)(n0 + n) * ldo + col_off + k0 + 8 * c) = o; }
    asm volatile("s_waitcnt lgkmcnt(0)" ::: "memory");
}

struct Params { const float* in[14]; float* out; unsigned char* ws; };

__device__ __forceinline__ void prologue_phase(const Params& p, LAS unsigned char* lds, int G, int vcu) {
    const int tid = threadIdx.x, wid = tid >> 6, lane = tid & 63;
    LAS float* scr = (LAS float*)(lds + wid * 16384);
    const int gw = vcu * 8 + wid, NGW = G * 8;
    bf16_t* WIN = (bf16_t*)(p.ws + WS_WIN); bf16_t* WBR = (bf16_t*)(p.ws + WS_WBR); bf16_t* WOUT = (bf16_t*)(p.ws + WS_WOUT);
    constexpr int I_IN = 16 * 152, I_BR = 8 * 32, I_OUT = 16 * 32, I_L = I_IN + 2 * I_BR + I_OUT;
    for (int it = gw; it < DEPTH * I_L; it += NGW) {
        const int l = it / I_L; int r = it % I_L;
        if (r < I_IN) { transpose_item(p.in[1] + (size_t)l * DM * NIN, NIN, WIN + (size_t)l * NIN * DM, DM, 0, scr, r, lane); continue; } r -= I_IN;
        if (r < I_BR) { transpose_item(p.in[8] + (size_t)l * 512 * DM, DM, WBR + (size_t)l * DM * DM, DM, 0, scr, r, lane); continue; } r -= I_BR;
        if (r < I_BR) { transpose_item(p.in[9] + (size_t)l * 512 * DM, DM, WBR + (size_t)l * DM * DM, DM, 512, scr, r, lane); continue; } r -= I_BR;
        transpose_item(p.in[10] + (size_t)l * DM * DM, DM, WOUT + (size_t)l * DM * DM, DM, 0, scr, r, lane);
    }
    const size_t gt = (size_t)vcu * 512 + tid, NGT = (size_t)G * 512;
    const f32x4* x4 = (const f32x4*)p.in[0]; u32x4* xb = (u32x4*)(p.ws + WS_XB);
    for (size_t i = gt; i < (size_t)MROWS * DM / 8; i += NGT) { const f32x4 a = x4[2 * i], b = x4[2 * i + 1];
        u32x4 o; o.x = pk2(a[0], a[1]); o.y = pk2(a[2], a[3]); o.z = pk2(b[0], b[1]); o.w = pk2(b[2], b[3]); xb[i] = o; }
    bf16_t* WSP = (bf16_t*)(p.ws + WS_WSP);
    for (size_t i = gt; i < (size_t)DEPTH * 4 * 128 * 128; i += NGT) { const int s = (int)(i & 127), t = (int)((i >> 7) & 127); WSP[i] = (bf16_t)(s <= t ? f2bf(p.in[6][i]) : 0u); }
}

constexpr int KL_PITCH = 144, KL_HEAD = 256 * KL_PITCH, VT_OFF = 2 * KL_HEAD, VT_PITCH = 528, VT_HEAD = 64 * VT_PITCH, VN_PITCH = 1032;
static_assert(VT_OFF + 2 * VT_HEAD <= LDS_BYTES && 128 * VN_PITCH <= LDS_BYTES, "LDS map");

__device__ __forceinline__ void mixer_phase(LAS unsigned char* lds, const bf16_t* H, bf16_t* Y, const bf16_t* Wsp, const float* sinks, const float* lng, const float* lnb, const float* bsp, int G, int vcu) {
    int tid_ = threadIdx.x; asm volatile("" : "+v"(tid_));
    const int tid = tid_, wid = __builtin_amdgcn_readfirstlane(tid >> 6), lane = tid & 63, fr = lane & 15, fq = lane >> 4;
    for (int item = vcu; item < MROWS / 128; item += G) {
        const int blk = item & 15; const size_t row0 = (size_t)item * 128;
#pragma unroll
        for (int j = 0; j < 8; ++j) { const int idx = tid + 512 * j, chunk = idx & 7, key = (idx >> 3) & 255, hk = idx >> 11;
            u32x4 v = (u32x4){0u, 0u, 0u, 0u};
            if (blk > 0 || key >= 128) v = *(const u32x4*)(H + (row0 + key - 128) * NIN + C_K + hk * 64 + chunk * 8);
            *(LAS u32x4*)(lds + hk * KL_HEAD + key * KL_PITCH + chunk * 16) = v; }
#pragma unroll
        for (int j = 0; j < 4; ++j) { const int idx = tid + 512 * j, kp = idx & 127, dc = (idx >> 7) & 7, hk = idx >> 10;
            u32x4 v0 = (u32x4){0u, 0u, 0u, 0u}, v1 = v0;
            if (blk > 0 || kp >= 64) { const bf16_t* src = H + (row0 + 2 * kp - 128) * NIN + C_V + hk * 64 + dc * 8; v0 = *(const u32x4*)src; v1 = *(const u32x4*)(src + NIN); }
            LAS unsigned char* dst = lds + VT_OFF + hk * VT_HEAD + (dc * 8) * VT_PITCH + kp * 4;
            *(LAS unsigned*)(dst + 0 * VT_PITCH) = (v0.x & 0xffffu) | (v1.x << 16); *(LAS unsigned*)(dst + 1 * VT_PITCH) = (v0.x >> 16) | (v1.x & 0xffff0000u);
            *(LAS unsigned*)(dst + 2 * VT_PITCH) = (v0.y & 0xffffu) | (v1.y << 16); *(LAS unsigned*)(dst + 3 * VT_PITCH) = (v0.y >> 16) | (v1.y & 0xffff0000u);
            *(LAS unsigned*)(dst + 4 * VT_PITCH) = (v0.z & 0xffffu) | (v1.z << 16); *(LAS unsigned*)(dst + 5 * VT_PITCH) = (v0.z >> 16) | (v1.z & 0xffff0000u);
            *(LAS unsigned*)(dst + 6 * VT_PITCH) = (v0.w & 0xffffu) | (v1.w << 16); *(LAS unsigned*)(dst + 7 * VT_PITCH) = (v0.w >> 16) | (v1.w & 0xffff0000u); }
        __syncthreads();
        {
            const int a = wid, st = a < 6 ? a : 6, qi = 16 * a + fr;
            const bf16_t* hrow = H + (row0 + qi) * NIN;
#pragma unroll 1
            for (int h = 0; h < 8; ++h) {
                const int hk = h >> 2;
                bf16x8 Qf[2]; Qf[0] = *(const bf16x8*)(hrow + C_Q + h * 64 + fq * 8); Qf[1] = *(const bf16x8*)(hrow + C_Q + h * 64 + 32 + fq * 8);
                f32x4 sc[10];
                const LAS unsigned char* kb = lds + hk * KL_HEAD + (16 * st + fr) * KL_PITCH + fq * 16;
#pragma unroll
                for (int t = 0; t < 10; ++t) { sc[t] = (f32x4){0.f, 0.f, 0.f, 0.f};
#pragma unroll
                    for (int ks = 0; ks < 2; ++ks) { const bf16x8 Kf = *(const LAS bf16x8*)(kb + t * 16 * KL_PITCH + ks * 64); sc[t] = MFMA16(Kf, Qf[ks], sc[t]); }
                    if ((t & 3) == 3) asm volatile("" ::: "memory"); }
                const float slope = exp2f(-(float)(h + 1)), sink = sinks[h];
                int dbase = qi + 128 - 16 * st - 4 * fq; asm volatile("" : "+v"(dbase));
                float mx = -INFINITY;
#pragma unroll
                for (int t = 0; t < 10; ++t)
#pragma unroll
                    for (int i = 0; i < 4; ++i) { const int dist = dbase - (16 * t + i), kj = qi + 128 - dist;
                        const bool valid = dist >= 0 && dist < 128 && (blk > 0 || kj >= 128);
                        const float v = valid ? sc[t][i] * 0.125f - slope * (float)dist : -INFINITY; sc[t][i] = v; mx = fmaxf(mx, v); }
                mx = fmaxf(mx, shx(mx, 16, lane)); mx = fmaxf(mx, shx(mx, 32, lane)); mx = fmaxf(mx, sink);
                float sum = 0.f;
#pragma unroll
                for (int t = 0; t < 10; ++t)
#pragma unroll
                    for (int i = 0; i < 4; ++i) { const float pv = __expf(sc[t][i] - mx); sc[t][i] = pv; sum += pv; }
                sum += shx(sum, 16, lane); sum += shx(sum, 32, lane);
                const float inv = 1.0f / (sum + __expf(sink - mx));
                f32x4 o[4];
#pragma unroll
                for (int dt = 0; dt < 4; ++dt) o[dt] = (f32x4){0.f, 0.f, 0.f, 0.f};
                const LAS unsigned char* vb = lds + VT_OFF + hk * VT_HEAD + fr * VT_PITCH + (16 * st + 4 * fq) * 2;
#pragma unroll
                for (int u = 0; u < 5; ++u) {
                    u32x4 pw; pw.x = cvt_pk_bf16(sc[2 * u][0], sc[2 * u][1]); pw.y = cvt_pk_bf16(sc[2 * u][2], sc[2 * u][3]);
                    pw.z = cvt_pk_bf16(sc[2 * u + 1][0], sc[2 * u + 1][1]); pw.w = cvt_pk_bf16(sc[2 * u + 1][2], sc[2 * u + 1][3]);
                    const bf16x8 Pf = __builtin_bit_cast(bf16x8, pw);
#pragma unroll
                    for (int dt = 0; dt < 4; ++dt) { const LAS unsigned char* ad = vb + dt * 16 * VT_PITCH + u * 64;
                        const s16x4 lo = *(const LAS s16x4*)ad, hi = *(const LAS s16x4*)(ad + 32);
                        const bf16x8 Vf = __builtin_shufflevector(lo, hi, 0, 1, 2, 3, 4, 5, 6, 7);
                        o[dt] = MFMA16(Vf, Pf, o[dt]); }
                    asm volatile("" ::: "memory"); }
#pragma unroll
                for (int dt = 0; dt < 4; ++dt) { const int col = h * 64 + 16 * dt + 4 * fq;
                    const u32x2 z = *(const u32x2*)(hrow + C_ZA + col);
                    u32x2 w; w.x = cvt_pk_bf16(o[dt][0] * inv * bf_lo(z.x), o[dt][1] * inv * bf_hi(z.x)); w.y = cvt_pk_bf16(o[dt][2] * inv * bf_lo(z.y), o[dt][3] * inv * bf_hi(z.y));
                    *(u32x2*)(Y + (row0 + qi) * DM + col) = w; }
            }
        }
        __syncthreads();
        {
            float gg[8], bb[8];
#pragma unroll
            for (int e = 0; e < 8; ++e) { gg[e] = lng[8 * lane + e]; bb[e] = lnb[8 * lane + e]; }
#pragma unroll 2
            for (int rr = 0; rr < 16; ++rr) { const int s = 16 * wid + rr;
                const u32x4 w = *(const u32x4*)(H + (row0 + s) * NIN + C_VG + 8 * lane);
                float x[8] = {bf_lo(w.x), bf_hi(w.x), bf_lo(w.y), bf_hi(w.y), bf_lo(w.z), bf_hi(w.z), bf_lo(w.w), bf_hi(w.w)};
                float sm = 0.f;
#pragma unroll
                for (int e = 0; e < 8; ++e) sm += x[e];
                const float mean = wave_sum(sm, lane) * (1.0f / 512.0f); float sq = 0.f;
#pragma unroll
                for (int e = 0; e < 8; ++e) { x[e] -= mean; sq += x[e] * x[e]; }
                const float rstd = rsqrtf(wave_sum(sq, lane) * (1.0f / 512.0f) + LN_EPS);
#pragma unroll
                for (int e = 0; e < 8; ++e) x[e] = x[e] * rstd * gg[e] + bb[e];
                u32x2 o0, o1; o0.x = cvt_pk_bf16(x[0], x[1]); o0.y = cvt_pk_bf16(x[2], x[3]); o1.x = cvt_pk_bf16(x[4], x[5]); o1.y = cvt_pk_bf16(x[6], x[7]);
                LAS unsigned char* dst = lds + s * VN_PITCH + lane * 16;
                *(LAS u32x2*)dst = o0; *(LAS u32x2*)(dst + 8) = o1; }
        }
        __syncthreads();
        {
            const int g = wid >> 1, dh = wid & 1, cbase = g * 128 + 64 * dh;
            const bf16_t* wg = Wsp + (size_t)g * 128 * 128;
#pragma unroll 1
            for (int dt = 0; dt < 4; ++dt) {
                bf16x8 Vn[4];
#pragma unroll
                for (int ks = 0; ks < 4; ++ks) { const LAS bf16_t* src = (const LAS bf16_t*)(lds + (32 * ks + 8 * fq) * VN_PITCH) + cbase + 16 * dt + fr;
#pragma unroll
                    for (int j = 0; j < 8; ++j) Vn[ks][j] = (short)src[j * (VN_PITCH / 2)]; }
                const int cc = cbase + 16 * dt + 4 * fq;
#pragma unroll 1
                for (int tt = 0; tt < 8; ++tt) {
                    f32x4 acc = (f32x4){0.f, 0.f, 0.f, 0.f};
                    const bf16_t* wrow = wg + (16 * tt + fr) * 128 + 8 * fq;
#pragma unroll
                    for (int ks = 0; ks < 4; ++ks) if (ks <= tt / 2) { const bf16x8 Wf = *(const bf16x8*)(wrow + 32 * ks); acc = MFMA16(Vn[ks], Wf, acc); }
                    const int t = 16 * tt + fr; const float bs = bsp[g * 128 + t];
                    const bf16_t* hrow = H + (row0 + t) * NIN;
                    const u32x2 uu = *(const u32x2*)(hrow + C_U + cc), zz = *(const u32x2*)(hrow + C_ZG + cc);
                    u32x2 w; w.x = cvt_pk_bf16(bf_lo(uu.x) * (acc[0] + bs) * bf_lo(zz.x), bf_hi(uu.x) * (acc[1] + bs) * bf_hi(zz.x));
                    w.y = cvt_pk_bf16(bf_lo(uu.y) * (acc[2] + bs) * bf_lo(zz.y), bf_hi(uu.y) * (acc[3] + bs) * bf_hi(zz.y));
                    *(u32x2*)(Y + (row0 + t) * DM + 512 + cc) = w;
                }
            }
        }
        __syncthreads();
    }
}

__device__ __forceinline__ void ln_phase(float* R, bf16_t* XB, const float* g, const float* b, int G, int vcu, bool write_bf) {
    int tid_ = threadIdx.x; asm volatile("" : "+v"(tid_));
    const int tid = tid_, wid = tid >> 6, lane = tid & 63;
    f32x4 gv[4], bv[4];
#pragma unroll
    for (int j = 0; j < 4; ++j) { gv[j] = ((const f32x4*)g)[lane + 64 * j]; bv[j] = ((const f32x4*)b)[lane + 64 * j]; }
    for (int m = vcu * 8 + wid; m < MROWS; m += G * 8) {
        f32x4* xr = (f32x4*)(R + (size_t)m * DM) + lane;
        f32x4 v[4]; float s = 0.f;
#pragma unroll
        for (int j = 0; j < 4; ++j) { v[j] = xr[64 * j]; s += (v[j][0] + v[j][1]) + (v[j][2] + v[j][3]); }
        const float mean = wave_sum(s, lane) * (1.f / DM); float s2 = 0.f;
#pragma unroll
        for (int j = 0; j < 4; ++j) { v[j] = v[j] - mean; s2 += (v[j][0] * v[j][0] + v[j][1] * v[j][1]) + (v[j][2] * v[j][2] + v[j][3] * v[j][3]); }
        const float rstd = rsqrtf(wave_sum(s2, lane) * (1.f / DM) + LN_EPS);
        u32x2* o8 = (u32x2*)(XB + (size_t)m * DM) + lane;
#pragma unroll
        for (int j = 0; j < 4; ++j) { const f32x4 y = v[j] * rstd * gv[j] + bv[j]; xr[64 * j] = y;
            if (write_bf) { u32x2 w; w.x = cvt_pk_bf16(y[0], y[1]); w.y = cvt_pk_bf16(y[2], y[3]); o8[64 * j] = w; } }
    }
}

#define XB_TMO      128
#define XB_XCNT(j)  (256  + 64 * (j))
#define XB_XSUB(j)  (1280 + 64 * (j))
#define XB_XGEN(j)  (2304 + 64 * (j))
#define XB_TOP      3328
#define XB_TOPGEN   3392
#define XCD_BAR_WORDS 3456
#define XB_SPIN_CAP (1u << 18)
__device__ __forceinline__ unsigned xb_ld(unsigned* p)              { return __hip_atomic_load(p, __ATOMIC_RELAXED, __HIP_MEMORY_SCOPE_AGENT); }
__device__ __forceinline__ unsigned xb_add(unsigned* p, unsigned v) { return __hip_atomic_fetch_add(p, v, __ATOMIC_RELAXED, __HIP_MEMORY_SCOPE_AGENT); }
__device__ __forceinline__ unsigned xb_xcc_id() { return (unsigned)__builtin_amdgcn_s_getreg((3 << 11) | 20) & 0xFu; }
#define XB_SPIN(cond, bar) do { unsigned _sp = 0; while (cond) { __builtin_amdgcn_s_sleep(1); \
    if ((++_sp & 255u) == 0u) { if (xb_ld(&(bar)[XB_TMO])) break; if (_sp > XB_SPIN_CAP) { atomicAdd(&(bar)[XB_TMO], 1u); break; } } } } while (0)
struct XcdBarrier { unsigned* bar; unsigned x; volatile LAS unsigned* st; };
__device__ __forceinline__ XcdBarrier xcd_barrier_post(unsigned* bar, volatile LAS unsigned* st) {
    XcdBarrier b; b.bar = bar; b.x = xb_xcc_id(); b.st = st;
    if (threadIdx.x == 0) (void)xb_add(&bar[XB_XCNT(b.x)], 1u);
    return b;
}
__device__ __forceinline__ void xcd_barrier_complete(unsigned* bar, unsigned x, unsigned& nloc, unsigned& nx) {
    const unsigned G = gridDim.x * gridDim.y * gridDim.z;
    unsigned sum, cnt, mine, sp = 0u;
    for (;;) {
        sum = 0u; cnt = 0u; mine = 0u;
#pragma unroll
        for (unsigned j = 0; j < 16; ++j) { const unsigned c = xb_ld(&bar[XB_XCNT(j)]); sum += c; cnt += (c > 0u) ? 1u : 0u; mine = (j == x) ? c : mine; }
        if (sum == G) break;
        __builtin_amdgcn_s_sleep(1);
        if ((++sp & 255u) == 0u) { if (xb_ld(&bar[XB_TMO])) break; if (sp > XB_SPIN_CAP) { atomicAdd(&bar[XB_TMO], 1u); break; } }
    }
    nloc = mine > 0u ? mine : 1u; nx = cnt > 0u ? cnt : 1u;
}
__device__ __forceinline__ void xcd_barrier(const XcdBarrier& b) {
    asm volatile("s_waitcnt vmcnt(0)" ::: "memory");
    __syncthreads();
    if (threadIdx.x == 0) {
        unsigned* bar = b.bar;
        __builtin_amdgcn_s_waitcnt(0);
        unsigned nloc = b.st[0], nx = b.st[1];
        if (nloc == 0u) { xcd_barrier_complete(bar, b.x, nloc, nx); b.st[0] = nloc; b.st[1] = nx; }
        const unsigned old = xb_add(&bar[XB_XSUB(b.x)], 1u);
        const unsigned gen = old / nloc;
        if (old + 1u == (gen + 1u) * nloc) {
            __builtin_amdgcn_fence(__ATOMIC_RELEASE, "agent");
            asm volatile("s_waitcnt vmcnt(0)" ::: "memory");
            const unsigned og = xb_add(&bar[XB_TOP], 1u);
            const unsigned tg = og / nx;
            if (og + 1u == (tg + 1u) * nx) xb_add(&bar[XB_TOPGEN], 1u);
            else XB_SPIN(xb_ld(&bar[XB_TOPGEN]) == tg, bar);
            __builtin_amdgcn_fence(__ATOMIC_ACQUIRE, "agent");
            xb_add(&bar[XB_XGEN(b.x)], 1u);
            asm volatile("s_waitcnt vmcnt(0)" ::: "memory");
        } else {
            XB_SPIN(xb_ld(&bar[XB_XGEN(b.x)]) == gen, bar);
            __builtin_amdgcn_fence(__ATOMIC_ACQUIRE, "agent");
            asm volatile("s_waitcnt vmcnt(0)" ::: "memory");
        }
    }
    __syncthreads();
}
#define grid_barrier(g) xcd_barrier(xbar)

__global__ void __launch_bounds__(512, 2) fwd_megakernel(Params p) {
    extern __shared__ __attribute__((aligned(16))) unsigned char lds_raw[];
    LAS unsigned char* lds = (LAS unsigned char*)lds_raw;
    cg::grid_group grid = cg::this_grid();
    const int G = gridDim.x, bx = blockIdx.x;
    const int vcu = (G % 8 == 0) ? (bx % 8) * (G / 8) + bx / 8 : bx;

    volatile LAS unsigned* xst = (volatile LAS unsigned*)(lds + LDS_BYTES - 64);
    if (threadIdx.x < 2) xst[threadIdx.x] = 0u;
    __syncthreads();
    XcdBarrier xbar = xcd_barrier_post((unsigned*)(p.ws + WS_CTL), xst);
    grid.sync();
    prologue_phase(p, lds, G, vcu);
    grid_barrier(grid);
#pragma unroll 1
    for (int l = 0; l < DEPTH; ++l) {
        unsigned char* ws = p.ws; asm volatile("" : "+s"(ws));
        bf16_t* WIN = (bf16_t*)(ws + WS_WIN); bf16_t* WBR = (bf16_t*)(ws + WS_WBR); bf16_t* WOUT = (bf16_t*)(ws + WS_WOUT); bf16_t* WSP = (bf16_t*)(ws + WS_WSP);
        bf16_t* XB = (bf16_t*)(ws + WS_XB); bf16_t* Y = (bf16_t*)(ws + WS_Y); bf16_t* H = (bf16_t*)(ws + WS_H);
        {
            pg8::Gemm g{XB, WIN + (size_t)l * NIN * DM, DM, DM, DM}; pg8::Order S; S.init(MROWS, NIN, G, bx, 1);
            pg8::EpiH E{H, p.in[2] + (size_t)l * NIN};
            pg8::gemm_phase<pg8::EpiH>(lds, g, S, E);
        }
        grid_barrier(grid);
        mixer_phase(lds, H, Y, WSP + (size_t)l * 4 * 128 * 128, p.in[3] + l * 8, p.in[4] + l * 512, p.in[5] + l * 512, p.in[7] + l * 512, G, vcu);
        grid_barrier(grid);
        {
            pg8::Gemm g{Y, WBR + (size_t)l * DM * DM, 512, DM, DM}; pg8::Order S; S.init(MROWS, DM, G, bx, 2);
            pg8::EpiMerge E{H};
            pg8::gemm_phase<pg8::EpiMerge>(lds, g, S, E);
        }
        grid_barrier(grid);
        {
            pg8::Gemm g{H, WOUT + (size_t)l * DM * DM, DM, NIN, DM}; pg8::Order S; S.init(MROWS, DM, G, bx, 1);
            pg8::EpiRes E{l == 0 ? p.in[0] : (const float*)p.out, p.out, p.in[11] + (size_t)l * DM};
            pg8::gemm_phase<pg8::EpiRes>(lds, g, S, E);
        }
        grid_barrier(grid);
        ln_phase(p.out, XB, p.in[12] + (size_t)l * DM, p.in[13] + (size_t)l * DM, G, vcu, l + 1 < DEPTH);
        if (l + 1 < DEPTH) grid_barrier(grid);
    }
}

extern "C" void kernel_launch(void* const* d_in, const int* in_sizes, int n_in, void* d_out, int out_size, void* d_ws, size_t ws_size, hipStream_t stream) {
    static int grid_blocks = 0;
    if (grid_blocks == 0) {
        if (n_in != 14 || out_size != MROWS * DM || ws_size < WS_END) { fprintf(stderr, "kernel_launch: unexpected shapes (n_in %d out %d ws %zu)\n", n_in, out_size, ws_size); grid_blocks = -1; return; }
        int dev = 0, cus = 0, per_cu = 0;
        hipGetDevice(&dev);
        hipDeviceGetAttribute(&cus, hipDeviceAttributeMultiprocessorCount, dev);
        hipFuncSetAttribute((const void*)fwd_megakernel, hipFuncAttributeMaxDynamicSharedMemorySize, LDS_BYTES);
        hipOccupancyMaxActiveBlocksPerMultiprocessor(&per_cu, (const void*)fwd_megakernel, 512, LDS_BYTES);
        if (per_cu < 1) { fprintf(stderr, "kernel_launch: occupancy query says %d blocks/CU\n", per_cu); per_cu = 1; }
        grid_blocks = cus * per_cu;
    }
    if (grid_blocks < 0) return;
    if (hipMemsetAsync((char*)d_ws + WS_CTL, 0, 16384, stream) != hipSuccess) { fprintf(stderr, "kernel_launch: memset failed\n"); return; }
    Params p{};
    for (int i = 0; i < 14; ++i) p.in[i] = (const float*)d_in[i];
    p.out = (float*)d_out; p.ws = (unsigned char*)d_ws;
    void* args[] = {&p};
    hipError_t e = hipLaunchCooperativeKernel((const void*)fwd_megakernel, dim3(grid_blocks), dim3(512), args, LDS_BYTES, stream);
    if (e != hipSuccess) fprintf(stderr, "cooperative launch failed: %s (grid %d)\n", hipGetErrorString(e), grid_blocks);
}
```

```cpp
#include <hip/hip_runtime.h>
#include <hip/hip_cooperative_groups.h>
#include <cstdio>
#include <cstdint>
namespace cg = cooperative_groups;

#define LAS __attribute__((address_space(3)))
typedef unsigned short bf16_t;
typedef short bf16x8 __attribute__((ext_vector_type(8)));
typedef short s16x4 __attribute__((ext_vector_type(4)));
typedef float f32x4 __attribute__((ext_vector_type(4)));
typedef float f32x2 __attribute__((ext_vector_type(2)));
typedef unsigned u32x4 __attribute__((ext_vector_type(4)));
typedef unsigned u32x2 __attribute__((ext_vector_type(2)));

constexpr int MROWS = 32768, DM = 1024, NIN = 4864, DEPTH = 4;
constexpr int C_Q = 0, C_K = 512, C_V = 640, C_ZA = 768, C_U = 1280, C_VG = 1792, C_ZG = 2304, C_GA = 2816, C_GG = 3840;
constexpr float ALPHA = 1.6817928305074290f;
constexpr float LN_EPS = 1e-5f;
constexpr size_t MiB = 1u << 20;
constexpr size_t WS_WIN = 0, WS_WBR = 38 * MiB, WS_WOUT = 46 * MiB, WS_WSP = 54 * MiB, WS_CTL = 55 * MiB, WS_XB = 56 * MiB, WS_Y = 120 * MiB, WS_H = 184 * MiB, WS_END = 488 * MiB;
constexpr int LDS_BYTES = 147456;

typedef __bf16 bf16x2_t __attribute__((ext_vector_type(2)));
__device__ __forceinline__ unsigned cvt_pk_bf16(float lo, float hi) { const f32x2 v = (f32x2){lo, hi}; const bf16x2_t r = __builtin_convertvector(v, bf16x2_t); return __builtin_bit_cast(unsigned, r); }
__device__ __forceinline__ float bf_lo(unsigned w) { return __uint_as_float(w << 16); }
__device__ __forceinline__ float bf_hi(unsigned w) { return __uint_as_float(w & 0xffff0000u); }
__device__ __forceinline__ float shx(float v, int o, int lane) { return __int_as_float(__builtin_amdgcn_ds_bpermute((lane ^ o) << 2, __float_as_int(v))); }
__device__ __forceinline__ float wave_sum(float v, int lane) {
#pragma unroll
    for (int o = 1; o < 64; o <<= 1) v += shx(v, o, lane);
    return v;
}
__device__ __forceinline__ float sigmoidf_(float v) { return __builtin_amdgcn_rcpf(1.0f + __expf(-v)); }
__device__ __forceinline__ f32x2 gelu_pk(f32x2 v) {
    const f32x2 av = __builtin_elementwise_abs(v), d = av * 0.2316418882f + 1.0f;
    f32x2 t; t.x = __builtin_amdgcn_rcpf(d.x); t.y = __builtin_amdgcn_rcpf(d.y);
    f32x2 q = t * 0.5307027145f + (-0.7265760135f); q = q * t + 0.7107068705f; q = q * t + (-0.142248368f); q = q * t + 0.127414796f; q = q * t;
    const f32x2 s = (v * v) * (-0.72134752044f);
    f32x2 e; e.x = __builtin_amdgcn_exp2f(s.x); e.y = __builtin_amdgcn_exp2f(s.y);
    const f32x2 m = v * (q * e), r = v - m;
    f32x2 o; o.x = v.x < 0.f ? m.x : r.x; o.y = v.y < 0.f ? m.y : r.y; return o;
}
template <int ACT> __device__ __forceinline__ f32x4 act4(f32x4 v) {
    if constexpr (ACT == 1) { f32x4 o; for (int j = 0; j < 4; ++j) o[j] = v[j] * sigmoidf_(v[j]); return o; }
    else if constexpr (ACT == 2) { const f32x2 a = gelu_pk((f32x2){v[0], v[1]}), b = gelu_pk((f32x2){v[2], v[3]}); return (f32x4){a.x, a.y, b.x, b.y}; }
    else if constexpr (ACT == 3) { f32x4 o; for (int j = 0; j < 4; ++j) o[j] = sigmoidf_(v[j]); return o; }
    else return v;
}

namespace pg8 {
constexpr int BM = 256, BK = 64, HALF = 128, HTB = HALF * BK * 2, NXCD = 8, WGM = 8;
__host__ __device__ __forceinline__ int lds_byte(int r, int c) { const int st = (r >> 4) * 2 + (c >> 5), rr = r & 15, cc = c & 31, ob = rr * 64 + cc * 2; return st * 1024 + (ob ^ (((ob >> 9) & 1) << 5)); }
__host__ __device__ __forceinline__ void stage_rc(int b, int& R, int& C) { const int st = b / 1024, sb = b % 1024, swz = sb ^ (((sb >> 9) & 1) << 5); R = (st >> 1) * 16 + swz / 64; C = (st & 1) * 32 + (swz % 64) / 2; }
__host__ __device__ __forceinline__ int perm32(int rho) { const int n = rho >> 4, i = rho & 15; return 8 * (i >> 2) + 4 * n + (i & 3); }

struct Unit { int pm, pn, kh; };
struct Gemm { const bf16_t* A; const bf16_t* Bt; int K, lda, ldb; };

struct Order {
    int nM, nN, nwg, G, c, halves;
    __device__ void init(int M, int N, int G_, int c_, int halves_) { nM = M / BM; nN = N / BM; nwg = nM * nN; G = G_; c = c_; halves = halves_; }
    __device__ bool next(int i, Unit& u) const {
        const int ti = (halves == 2) ? (i >> 1) : i; u.kh = (halves == 2) ? (i & 1) : 0;
        const long L = (long)ti * G + c; if (L >= nwg) return false;
        int wgid = (int)L; { const int q = nwg / NXCD, r = nwg % NXCD, xcd = wgid % NXCD, off = wgid / NXCD; wgid = (xcd < r ? xcd * (q + 1) : r * (q + 1) + (xcd - r) * q) + off; }
        const int nig = WGM * nN, gid = wgid / nig, fm = gid * WGM, gsz = (nM - fm) < WGM ? (nM - fm) : WGM;
        u.pm = fm + ((wgid % nig) % gsz); u.pn = (wgid % nig) / gsz; return true;
    }
};

typedef f32x4 Acc[2][2][4][2];

struct EpiH {
    static constexpr bool PERM = true;
    bf16_t* H; const float* bias;
    __device__ __forceinline__ bool keep(const Unit&) const { return false; }
    template <int ACT> __device__ __forceinline__ void body(const Acc& acc, const Unit& u, int wr, int wc, int fr, int fq) const {
        const int row0 = u.pm * BM + wr * 64 + fr, col0 = u.pn * BM + wc * 32 + 8 * fq;
#pragma unroll
        for (int bj = 0; bj < 2; ++bj) {
            const f32x4 bv0 = *(const f32x4*)(bias + col0 + bj * HALF), bv1 = *(const f32x4*)(bias + col0 + bj * HALF + 4);
#pragma unroll
            for (int ai = 0; ai < 2; ++ai)
#pragma unroll
                for (int m = 0; m < 4; ++m) { bf16_t* rowp = H + (size_t)(row0 + ai * HALF + m * 16) * NIN + col0 + bj * HALF;
                    const f32x4 v0 = act4<ACT>(acc[ai][bj][m][0] + bv0), v1 = act4<ACT>(acc[ai][bj][m][1] + bv1);
                    u32x4 w; w.x = cvt_pk_bf16(v0[0], v0[1]); w.y = cvt_pk_bf16(v0[2], v0[3]); w.z = cvt_pk_bf16(v1[0], v1[1]); w.w = cvt_pk_bf16(v1[2], v1[3]);
                    *(u32x4*)rowp = w; }
        }
    }
    __device__ __forceinline__ void operator()(Acc& acc, const Unit& u, int wr, int wc, int fr, int fq) const {
        const int pn = u.pn;
        if (pn < 3) body<0>(acc, u, wr, wc, fr, fq);
        else if (pn < 5 || (pn >= 9 && pn < 11)) body<1>(acc, u, wr, wc, fr, fq);
        else if (pn < 9) body<2>(acc, u, wr, wc, fr, fq);
        else body<3>(acc, u, wr, wc, fr, fq);
    }
};
struct EpiMerge {
    static constexpr bool PERM = true;
    bf16_t* H;
    __device__ __forceinline__ bool keep(const Unit& u) const { return u.kh == 0; }
    __device__ __forceinline__ void operator()(Acc& acc, const Unit& u, int wr, int wc, int fr, int fq) const {
        const int row0 = u.pm * BM + wr * 64 + fr, col0 = u.pn * BM + wc * 32 + 8 * fq;
#pragma unroll
        for (int ai = 0; ai < 2; ++ai)
#pragma unroll
            for (int m = 0; m < 4; ++m) { bf16_t* rowp = H + (size_t)(row0 + ai * HALF + m * 16) * NIN + col0;
#pragma unroll
                for (int bj = 0; bj < 2; ++bj) {
                    const u32x4 g = *(const u32x4*)(rowp + C_GG + bj * HALF);
                    const f32x4 sg0 = (f32x4){bf_lo(g.x), bf_hi(g.x), bf_lo(g.y), bf_hi(g.y)}, sg1 = (f32x4){bf_lo(g.z), bf_hi(g.z), bf_lo(g.w), bf_hi(g.w)};
                    if (u.kh == 0) {
                        const u32x4 a = *(const u32x4*)(rowp + C_GA + bj * HALF);
                        const f32x4 sa0 = (f32x4){bf_lo(a.x), bf_hi(a.x), bf_lo(a.y), bf_hi(a.y)}, sa1 = (f32x4){bf_lo(a.z), bf_hi(a.z), bf_lo(a.w), bf_hi(a.w)};
#pragma unroll
                        for (int j = 0; j < 4; ++j) { acc[ai][bj][m][0][j] *= sa0[j] * __builtin_amdgcn_rcpf(sg0[j]); acc[ai][bj][m][1][j] *= sa1[j] * __builtin_amdgcn_rcpf(sg1[j]); }
                    } else {
                        const f32x4 v0 = acc[ai][bj][m][0] * sg0, v1 = acc[ai][bj][m][1] * sg1;
                        u32x4 w; w.x = cvt_pk_bf16(v0[0], v0[1]); w.y = cvt_pk_bf16(v0[2], v0[3]); w.z = cvt_pk_bf16(v1[0], v1[1]); w.w = cvt_pk_bf16(v1[2], v1[3]);
                        *(u32x4*)(rowp + bj * HALF) = w;
                    } }
                asm volatile("" ::: "memory"); }
    }
};
struct EpiRes {
    static constexpr bool PERM = false;
    const float* xin; float* R; const float* bias;
    __device__ __forceinline__ bool keep(const Unit&) const { return false; }
    __device__ __forceinline__ void operator()(Acc& acc, const Unit& u, int wr, int wc, int fr, int fq) const {
        const int row0 = u.pm * BM + wr * 64 + fr, col0 = u.pn * BM + wc * 32 + 4 * fq;
        f32x4 bv[2][2];
#pragma unroll
        for (int bj = 0; bj < 2; ++bj)
#pragma unroll
            for (int n = 0; n < 2; ++n) bv[bj][n] = *(const f32x4*)(bias + col0 + bj * HALF + n * 16);
#pragma unroll
        for (int ai = 0; ai < 2; ++ai)
#pragma unroll
            for (int m = 0; m < 4; ++m) { const size_t off = (size_t)(row0 + ai * HALF + m * 16) * DM + col0;
#pragma unroll
                for (int bj = 0; bj < 2; ++bj)
#pragma unroll
                    for (int n = 0; n < 2; ++n) { const f32x4 xv = *(const f32x4*)(xin + off + bj * HALF + n * 16);
                        *(f32x4*)(R + off + bj * HALF + n * 16) = xv * ALPHA + acc[ai][bj][m][n] + bv[bj][n]; }
                asm volatile("" ::: "memory"); }
    }
};

template <class Epi>
__device__ __forceinline__ void gemm_phase(LAS unsigned char* lds, const Gemm g, const Order& S, const Epi& E) {
    int tid_ = threadIdx.x; asm volatile("" : "+v"(tid_));
    const int tid = tid_, wid = __builtin_amdgcn_readfirstlane(tid >> 6), lane = tid & 63, wr = wid >> 2, wc = wid & 3, fr = lane & 15, fq = lane >> 4;
    const int K = g.K, nt = K / BK;
    unsigned voffA[2], voffB[2];
#pragma unroll
    for (int i = 0; i < 2; ++i) { int R, C; stage_rc(tid * 16 + i * 8192, R, C); const int Rb = Epi::PERM ? ((R & ~31) + perm32(R & 31)) : R;
        voffA[i] = (unsigned)(R * g.lda + C) * 2u; voffB[i] = (unsigned)(Rb * g.ldb + C) * 2u; }
    const size_t kstep = (size_t)(BK * 2);
    const size_t hstepA = (size_t)HALF * g.lda * 2, hstepB = (size_t)HALF * g.ldb * 2;
    const size_t tstepA = 2 * hstepA, tstepB = 2 * hstepB, khstep = (size_t)K * 2;
    const unsigned ldsw = (unsigned)wid * 1024u;
    const int aoff = lds_byte(wr * 64 + fr, fq * 8), boff = lds_byte(wc * 32 + fr, fq * 8);
#define PG8_SA(b, h) (((b) * 2 + (h)) * HTB)
#define PG8_SB(b, h) ((4 + (b) * 2 + (h)) * HTB)
#define PG8_STAGE(bufoff, gbase, voff) do { _Pragma("unroll") for (int _i = 0; _i < 2; ++_i) \
        __builtin_amdgcn_global_load_lds((const unsigned*)((const char*)(gbase) + (voff)[_i]), (LAS unsigned*)(lds + (bufoff) + ldsw + _i * 8192), 16, 0, 0); } while (0)
#define PG8_LDA(dst, b, h) do { _Pragma("unroll") for (int m = 0; m < 4; ++m) _Pragma("unroll") for (int k = 0; k < 2; ++k) dst[m][k] = *(const LAS bf16x8*)(lds + PG8_SA(b, h) + aoff + m * 2048 + k * 1024); } while (0)
#define PG8_LDB(dst, b, h) do { _Pragma("unroll") for (int n = 0; n < 2; ++n) _Pragma("unroll") for (int k = 0; k < 2; ++k) dst[n][k] = *(const LAS bf16x8*)(lds + PG8_SB(b, h) + boff + n * 2048 + k * 1024); } while (0)
#define PG8_MMA(ai, bj, At, Bt) do { __builtin_amdgcn_s_setprio(1); _Pragma("unroll") for (int m = 0; m < 4; ++m) _Pragma("unroll") for (int n = 0; n < 2; ++n) _Pragma("unroll") for (int k = 0; k < 2; ++k) \
        acc[ai][bj][m][n] = __builtin_amdgcn_mfma_f32_16x16x32_bf16(Bt[n][k], At[m][k], acc[ai][bj][m][n], 0, 0, 0); __builtin_amdgcn_s_setprio(0); } while (0)
#define PG8_WAIT_V(n) asm volatile("s_waitcnt vmcnt(" #n ")" ::: "memory")
#define PG8_WAIT_L(n) asm volatile("s_waitcnt lgkmcnt(" #n ")" ::: "memory")
#define PG8_BAR __builtin_amdgcn_s_barrier()
#define PG8_SCHED __builtin_amdgcn_sched_barrier(0)
    Unit cur, nxt; int ui = 0;
    if (!S.next(0, cur)) return;
    Acc acc;
#pragma unroll
    for (int a = 0; a < 2; ++a)
#pragma unroll
        for (int b = 0; b < 2; ++b)
#pragma unroll
            for (int m = 0; m < 4; ++m)
#pragma unroll
                for (int n = 0; n < 2; ++n) acc[a][b][m][n] = (f32x4){0.f, 0.f, 0.f, 0.f};
    bf16x8 At[4][2], B0[2][2], B1[2][2];
    const char* cA = (const char*)g.A + (size_t)cur.pm * tstepA + (size_t)cur.kh * khstep; const char* cB = (const char*)g.Bt + (size_t)cur.pn * tstepB + (size_t)cur.kh * khstep;
    PG8_STAGE(PG8_SB(0, 0), cB, voffB); PG8_STAGE(PG8_SB(0, 1), cB + hstepB, voffB); PG8_STAGE(PG8_SA(0, 0), cA, voffA); PG8_STAGE(PG8_SA(0, 1), cA + hstepA, voffA);
    if (wr == 1) PG8_BAR;
    PG8_WAIT_V(2); PG8_BAR;
    PG8_STAGE(PG8_SB(1, 0), cB + kstep, voffB); PG8_STAGE(PG8_SA(1, 0), cA + kstep, voffA); PG8_STAGE(PG8_SB(1, 1), cB + hstepB + kstep, voffB);
    PG8_WAIT_V(6); PG8_BAR;
    for (;;) {
        const bool has_next = S.next(ui + 1, nxt);
        const char* nA = has_next ? (const char*)g.A + (size_t)nxt.pm * tstepA + (size_t)nxt.kh * khstep : cA;
        const char* nB = has_next ? (const char*)g.Bt + (size_t)nxt.pn * tstepB + (size_t)nxt.kh * khstep : cB;
        for (int t = 0; t < nt; t += 2) {
            const bool last = (t == nt - 2);
            const char* a1 = cA + (size_t)(t + 1) * kstep;
            const char* a2 = last ? nA : cA + (size_t)(t + 2) * kstep; const char* b2 = last ? nB : cB + (size_t)(t + 2) * kstep;
            const char* a3 = a2 + kstep; const char* b3 = b2 + kstep;
            PG8_LDB(B0, 0, 0); PG8_LDB(B1, 0, 1); PG8_SCHED; PG8_LDA(At, 0, 0); PG8_STAGE(PG8_SA(1, 1), a1 + hstepA, voffA);
            PG8_WAIT_V(8); PG8_WAIT_L(0); PG8_BAR; PG8_MMA(0, 0, At, B0); PG8_MMA(0, 1, At, B1); PG8_BAR; PG8_SCHED;
            PG8_LDA(At, 0, 1); PG8_STAGE(PG8_SB(0, 0), b2, voffB); PG8_STAGE(PG8_SB(0, 1), b2 + hstepB, voffB); PG8_STAGE(PG8_SA(0, 0), a2, voffA);
            PG8_WAIT_V(8); PG8_WAIT_L(0); PG8_BAR; PG8_MMA(1, 0, At, B0); PG8_MMA(1, 1, At, B1); PG8_BAR; PG8_SCHED;
            PG8_LDB(B0, 1, 0); PG8_LDB(B1, 1, 1); PG8_SCHED; PG8_LDA(At, 1, 0); PG8_STAGE(PG8_SA(0, 1), a2 + hstepA, voffA);
            PG8_WAIT_V(8); PG8_WAIT_L(0); PG8_BAR; PG8_MMA(0, 0, At, B0); PG8_MMA(0, 1, At, B1); PG8_BAR; PG8_SCHED;
            PG8_LDA(At, 1, 1); PG8_STAGE(PG8_SB(1, 0), b3, voffB); PG8_STAGE(PG8_SB(1, 1), b3 + hstepB, voffB); PG8_STAGE(PG8_SA(1, 0), a3, voffA);
            PG8_WAIT_V(8); PG8_WAIT_L(0); PG8_BAR; PG8_MMA(1, 0, At, B0); PG8_MMA(1, 1, At, B1); PG8_BAR; PG8_SCHED;
        }
        if (wr == 0) PG8_BAR;
        E(acc, cur, wr, wc, fr, fq);
        if (!has_next) break;
        if (!E.keep(cur)) {
#pragma unroll
            for (int a = 0; a < 2; ++a)
#pragma unroll
                for (int b = 0; b < 2; ++b)
#pragma unroll
                    for (int m = 0; m < 4; ++m)
#pragma unroll
                        for (int n = 0; n < 2; ++n) acc[a][b][m][n] = (f32x4){0.f, 0.f, 0.f, 0.f};
        }
        cur = nxt; cA = nA; cB = nB; ++ui;
        if (wr == 1) PG8_BAR;
    }
    PG8_WAIT_V(0);
    PG8_BAR;
#undef PG8_SA
#undef PG8_SB
#undef PG8_STAGE
#undef PG8_LDA
#undef PG8_LDB
#undef PG8_MMA
#undef PG8_WAIT_V
#undef PG8_WAIT_L
#undef PG8_BAR
#undef PG8_SCHED
}
}

#define MFMA16(a, b, c) __builtin_amdgcn_mfma_f32_16x16x32_bf16((a), (b), (c), 0, 0, 0)

__device__ __forceinline__ unsigned f2bf(float f) { unsigned u = __float_as_uint(f); return (u + 0x7fffu + ((u >> 16) & 1u)) >> 16; }
__device__ __forceinline__ unsigned pk2(float lo, float hi) { return f2bf(lo) | (f2bf(hi) << 16); }
__device__ __forceinline__ void transpose_item(const float* W, int N, bf16_t* WT, int ldo, int col_off, LAS float* scr, int item, int lane) {
    const int nblk = N / 32, kb = item / nblk, nb = item % nblk, k0 = 64 * kb, n0 = 32 * nb;
#pragma unroll 8
    for (int i = 0; i < 32; ++i) { const int kk = 2 * i + (lane >> 5); scr[kk * 33 + (lane & 31)] = W[(size_t)(k0 + kk) * N + n0 + (lane & 31)]; }
    asm volatile("s_waitcnt lgkmcnt(0)" ::: "memory");
    const int c = lane & 7;
#pragma unroll
    for (int j = 0; j < 4; ++j) { const int n = (lane >> 3) + 8 * j; const LAS float* s = scr + (8 * c) * 33 + n;
        u32x4 o; o.x = pk2(s[0 * 33], s[1 * 33]); o.y = pk2(s[2 * 33], s[3 * 33]); o.z = pk2(s[4 * 33], s[5 * 33]); o.w = pk2(s[6 * 33], s[7 * 33]);
        *(u32x4*)(WT + (size_t)(n0 + n) * ldo + col_off + k0 + 8 * c) = o; }
    asm volatile("s_waitcnt lgkmcnt(0)" ::: "memory");
}

struct Params { const float* in[14]; float* out; unsigned char* ws; };

__device__ __forceinline__ void prologue_phase(const Params& p, LAS unsigned char* lds, int G, int vcu) {
    const int tid = threadIdx.x, wid = tid >> 6, lane = tid & 63;
    LAS float* scr = (LAS float*)(lds + wid * 16384);
    const int gw = vcu * 8 + wid, NGW = G * 8;
    bf16_t* WIN = (bf16_t*)(p.ws + WS_WIN); bf16_t* WBR = (bf16_t*)(p.ws + WS_WBR); bf16_t* WOUT = (bf16_t*)(p.ws + WS_WOUT);
    constexpr int I_IN = 16 * 152, I_BR = 8 * 32, I_OUT = 16 * 32, I_L = I_IN + 2 * I_BR + I_OUT;
    for (int it = gw; it < DEPTH * I_L; it += NGW) {
        const int l = it / I_L; int r = it % I_L;
        if (r < I_IN) { transpose_item(p.in[1] + (size_t)l * DM * NIN, NIN, WIN + (size_t)l * NIN * DM, DM, 0, scr, r, lane); continue; } r -= I_IN;
        if (r < I_BR) { transpose_item(p.in[8] + (size_t)l * 512 * DM, DM, WBR + (size_t)l * DM * DM, DM, 0, scr, r, lane); continue; } r -= I_BR;
        if (r < I_BR) { transpose_item(p.in[9] + (size_t)l * 512 * DM, DM, WBR + (size_t)l * DM * DM, DM, 512, scr, r, lane); continue; } r -= I_BR;
        transpose_item(p.in[10] + (size_t)l * DM * DM, DM, WOUT + (size_t)l * DM * DM, DM, 0, scr, r, lane);
    }
    const size_t gt = (size_t)vcu * 512 + tid, NGT = (size_t)G * 512;
    const f32x4* x4 = (const f32x4*)p.in[0]; u32x4* xb = (u32x4*)(p.ws + WS_XB);
    for (size_t i = gt; i < (size_t)MROWS * DM / 8; i += NGT) { const f32x4 a = x4[2 * i], b = x4[2 * i + 1];
        u32x4 o; o.x = pk2(a[0], a[1]); o.y = pk2(a[2], a[3]); o.z = pk2(b[0], b[1]); o.w = pk2(b[2], b[3]); xb[i] = o; }
    bf16_t* WSP = (bf16_t*)(p.ws + WS_WSP);
    for (size_t i = gt; i < (size_t)DEPTH * 4 * 128 * 128; i += NGT) { const int s = (int)(i & 127), t = (int)((i >> 7) & 127); WSP[i] = (bf16_t)(s <= t ? f2bf(p.in[6][i]) : 0u); }
}

constexpr int KL_PITCH = 144, KL_HEAD = 256 * KL_PITCH, VT_OFF = 2 * KL_HEAD, VT_PITCH = 528, VT_HEAD = 64 * VT_PITCH, VN_PITCH = 1032;
static_assert(VT_OFF + 2 * VT_HEAD <= LDS_BYTES && 128 * VN_PITCH <= LDS_BYTES, "LDS map");

__device__ __forceinline__ f32x4 bf4_lo(u32x4 w) { return (f32x4){bf_lo(w.x), bf_hi(w.x), bf_lo(w.y), bf_hi(w.y)}; }
__device__ __forceinline__ f32x4 bf4_hi(u32x4 w) { return (f32x4){bf_lo(w.z), bf_hi(w.z), bf_lo(w.w), bf_hi(w.w)}; }
__device__ __forceinline__ u32x4 pack8(f32x4 a, f32x4 b) { u32x4 w; w.x = cvt_pk_bf16(a[0], a[1]); w.y = cvt_pk_bf16(a[2], a[3]); w.z = cvt_pk_bf16(b[0], b[1]); w.w = cvt_pk_bf16(b[2], b[3]); return w; }

__device__ __forceinline__ void mixer_phase(LAS unsigned char* lds, const bf16_t* H, bf16_t* Y, const bf16_t* Wsp, const float* sinks, const float* lng, const float* lnb, const float* bsp, int G, int vcu) {
    int tid_ = threadIdx.x; asm volatile("" : "+v"(tid_));
    const int tid = tid_, wid = __builtin_amdgcn_readfirstlane(tid >> 6), lane = tid & 63, fr = lane & 15, fq = lane >> 4;
    const int prow = 8 * (fr >> 2) + (fr & 3);
    for (int item = vcu; item < MROWS / 128; item += G) {
        const int blk = item & 15; const size_t row0 = (size_t)item * 128;
        {
            u32x4 kv[8], va[4], vb2[4];
#pragma unroll
            for (int j = 0; j < 8; ++j) { const int idx = tid + 512 * j, chunk = idx & 7, key = (idx >> 3) & 255, hk = idx >> 11;
                kv[j] = (u32x4){0u, 0u, 0u, 0u};
                if (blk > 0 || key >= 128) kv[j] = *(const u32x4*)(H + (row0 + key - 128) * NIN + C_K + hk * 64 + chunk * 8); }
#pragma unroll
            for (int j = 0; j < 4; ++j) { const int idx = tid + 512 * j, kp = idx & 127, dc = (idx >> 7) & 7, hk = idx >> 10;
                va[j] = (u32x4){0u, 0u, 0u, 0u}; vb2[j] = va[j];
                if (blk > 0 || kp >= 64) { const bf16_t* src = H + (row0 + 2 * kp - 128) * NIN + C_V + hk * 64 + dc * 8; va[j] = *(const u32x4*)src; vb2[j] = *(const u32x4*)(src + NIN); } }
#pragma unroll
            for (int j = 0; j < 8; ++j) { const int idx = tid + 512 * j, chunk = idx & 7, key = (idx >> 3) & 255, hk = idx >> 11;
                *(LAS u32x4*)(lds + hk * KL_HEAD + key * KL_PITCH + chunk * 16) = kv[j]; }
#pragma unroll
            for (int j = 0; j < 4; ++j) { const int idx = tid + 512 * j, kp = idx & 127, dc = (idx >> 7) & 7, hk = idx >> 10;
                const u32x4 v0 = va[j], v1 = vb2[j];
                LAS unsigned char* dst = lds + VT_OFF + hk * VT_HEAD + (dc * 8) * VT_PITCH + kp * 4;
                *(LAS unsigned*)(dst + 0 * VT_PITCH) = (v0.x & 0xffffu) | (v1.x << 16); *(LAS unsigned*)(dst + 1 * VT_PITCH) = (v0.x >> 16) | (v1.x & 0xffff0000u);
                *(LAS unsigned*)(dst + 2 * VT_PITCH) = (v0.y & 0xffffu) | (v1.y << 16); *(LAS unsigned*)(dst + 3 * VT_PITCH) = (v0.y >> 16) | (v1.y & 0xffff0000u);
                *(LAS unsigned*)(dst + 4 * VT_PITCH) = (v0.z & 0xffffu) | (v1.z << 16); *(LAS unsigned*)(dst + 5 * VT_PITCH) = (v0.z >> 16) | (v1.z & 0xffff0000u);
                *(LAS unsigned*)(dst + 6 * VT_PITCH) = (v0.w & 0xffffu) | (v1.w << 16); *(LAS unsigned*)(dst + 7 * VT_PITCH) = (v0.w >> 16) | (v1.w & 0xffff0000u); }
        }
        {
            const int a = wid, st = a < 6 ? a : 6, qi = 16 * a + fr;
            const bf16_t* hrow = H + (row0 + qi) * NIN;
            bf16x8 Qn0 = *(const bf16x8*)(hrow + C_Q + fq * 8), Qn1 = *(const bf16x8*)(hrow + C_Q + 32 + fq * 8);
            u32x4 Zn0 = *(const u32x4*)(hrow + C_ZA + 8 * fq), Zn1 = *(const u32x4*)(hrow + C_ZA + 32 + 8 * fq);
            __syncthreads();
#pragma unroll 1
            for (int h = 0; h < 8; ++h) {
                const int hk = h >> 2, hn = h < 7 ? h + 1 : 7;
                const bf16x8 Q0 = Qn0, Q1 = Qn1; const u32x4 Z0 = Zn0, Z1 = Zn1;
                Qn0 = *(const bf16x8*)(hrow + C_Q + hn * 64 + fq * 8); Qn1 = *(const bf16x8*)(hrow + C_Q + hn * 64 + 32 + fq * 8);
                Zn0 = *(const u32x4*)(hrow + C_ZA + hn * 64 + 8 * fq); Zn1 = *(const u32x4*)(hrow + C_ZA + hn * 64 + 32 + 8 * fq);
                f32x4 sc[10];
                const LAS unsigned char* kb = lds + hk * KL_HEAD + (16 * st + fr) * KL_PITCH + fq * 16;
#pragma unroll
                for (int t = 0; t < 10; ++t) { sc[t] = (f32x4){0.f, 0.f, 0.f, 0.f};
                    const bf16x8 Kf0 = *(const LAS bf16x8*)(kb + t * 16 * KL_PITCH), Kf1 = *(const LAS bf16x8*)(kb + t * 16 * KL_PITCH + 64);
                    sc[t] = MFMA16(Kf0, Q0, sc[t]); sc[t] = MFMA16(Kf1, Q1, sc[t]);
                    if ((t & 3) == 3) asm volatile("" ::: "memory"); }
                const float slope = exp2f(-(float)(h + 1)), sink = sinks[h];
                int dbase = qi + 128 - 16 * st - 4 * fq; asm volatile("" : "+v"(dbase));
                float mx = -INFINITY;
#pragma unroll
                for (int t = 0; t < 10; ++t)
#pragma unroll
                    for (int i = 0; i < 4; ++i) { const int dist = dbase - (16 * t + i), kj = qi + 128 - dist;
                        const bool valid = dist >= 0 && dist < 128 && (blk > 0 || kj >= 128);
                        const float v = valid ? sc[t][i] * 0.125f - slope * (float)dist : -INFINITY; sc[t][i] = v; mx = fmaxf(mx, v); }
                mx = fmaxf(mx, shx(mx, 16, lane)); mx = fmaxf(mx, shx(mx, 32, lane)); mx = fmaxf(mx, sink);
                float sum = 0.f;
#pragma unroll
                for (int t = 0; t < 10; ++t)
#pragma unroll
                    for (int i = 0; i < 4; ++i) { const float pv = __expf(sc[t][i] - mx); sc[t][i] = pv; sum += pv; }
                sum += shx(sum, 16, lane); sum += shx(sum, 32, lane);
                const float inv = 1.0f / (sum + __expf(sink - mx));
                f32x4 o[4];
#pragma unroll
                for (int dt = 0; dt < 4; ++dt) o[dt] = (f32x4){0.f, 0.f, 0.f, 0.f};
                const LAS unsigned char* vb = lds + VT_OFF + hk * VT_HEAD + prow * VT_PITCH + (16 * st + 4 * fq) * 2;
#pragma unroll
                for (int u = 0; u < 5; ++u) {
                    const bf16x8 Pf = __builtin_bit_cast(bf16x8, pack8(sc[2 * u], sc[2 * u + 1]));
#pragma unroll
                    for (int dt = 0; dt < 4; ++dt) { const LAS unsigned char* ad = vb + (32 * (dt >> 1) + 4 * (dt & 1)) * VT_PITCH + u * 64;
                        const s16x4 lo = *(const LAS s16x4*)ad, hi = *(const LAS s16x4*)(ad + 32);
                        const bf16x8 Vf = __builtin_shufflevector(lo, hi, 0, 1, 2, 3, 4, 5, 6, 7);
                        o[dt] = MFMA16(Vf, Pf, o[dt]); }
                    asm volatile("" ::: "memory"); }
                bf16_t* yrow = Y + (row0 + qi) * DM + h * 64 + 8 * fq;
                *(u32x4*)yrow = pack8(o[0] * inv * bf4_lo(Z0), o[1] * inv * bf4_hi(Z0));
                *(u32x4*)(yrow + 32) = pack8(o[2] * inv * bf4_lo(Z1), o[3] * inv * bf4_hi(Z1));
            }
        }
        {
            u32x4 vr[16];
#pragma unroll
            for (int rr = 0; rr < 16; ++rr) vr[rr] = *(const u32x4*)(H + (row0 + 16 * wid + rr) * NIN + C_VG + 8 * lane);
            float gg[8], bb[8];
#pragma unroll
            for (int e = 0; e < 8; ++e) { gg[e] = lng[8 * lane + e]; bb[e] = lnb[8 * lane + e]; }
            __syncthreads();
#pragma unroll
            for (int rr = 0; rr < 16; ++rr) { const int s = 16 * wid + rr; const u32x4 w = vr[rr];
                float x[8] = {bf_lo(w.x), bf_hi(w.x), bf_lo(w.y), bf_hi(w.y), bf_lo(w.z), bf_hi(w.z), bf_lo(w.w), bf_hi(w.w)};
                float sm = 0.f;
#pragma unroll
                for (int e = 0; e < 8; ++e) sm += x[e];
                const float mean = wave_sum(sm, lane) * (1.0f / 512.0f); float sq = 0.f;
#pragma unroll
                for (int e = 0; e < 8; ++e) { x[e] -= mean; sq += x[e] * x[e]; }
                const float rstd = rsqrtf(wave_sum(sq, lane) * (1.0f / 512.0f) + LN_EPS);
#pragma unroll
                for (int e = 0; e < 8; ++e) x[e] = x[e] * rstd * gg[e] + bb[e];
                u32x2 o0, o1; o0.x = cvt_pk_bf16(x[0], x[1]); o0.y = cvt_pk_bf16(x[2], x[3]); o1.x = cvt_pk_bf16(x[4], x[5]); o1.y = cvt_pk_bf16(x[6], x[7]);
                LAS unsigned char* dst = lds + s * VN_PITCH + lane * 16;
                *(LAS u32x2*)dst = o0; *(LAS u32x2*)(dst + 8) = o1; }
        }
        __syncthreads();
        {
            const int g = wid >> 1, dh = wid & 1;
            const bf16_t* wg = Wsp + (size_t)g * 128 * 128 + fr * 128 + 8 * fq;
            const float* bsg = bsp + g * 128 + fr;
#pragma unroll 1
            for (int p = 0; p < 2; ++p) {
                const int cbase = g * 128 + 64 * dh + 32 * p;
                bf16x8 Vn[4][2];
#pragma unroll
                for (int ks = 0; ks < 4; ++ks)
#pragma unroll
                    for (int d2 = 0; d2 < 2; ++d2) { const LAS bf16_t* src = (const LAS bf16_t*)(lds + (32 * ks + 8 * fq) * VN_PITCH) + cbase + 4 * d2 + prow;
#pragma unroll
                        for (int j = 0; j < 8; ++j) Vn[ks][d2][j] = (short)src[j * (VN_PITCH / 2)]; }
                const bf16_t* hbase = H + (row0 + fr) * NIN + cbase + 8 * fq;
                bf16_t* ybase = Y + (row0 + fr) * DM + 512 + cbase + 8 * fq;
                bf16x8 Wn[4]; u32x4 Un, Zn; float bsn;
#pragma unroll
                for (int ks = 0; ks < 4; ++ks) Wn[ks] = *(const bf16x8*)(wg + 32 * ks);
                Un = *(const u32x4*)(hbase + C_U); Zn = *(const u32x4*)(hbase + C_ZG); bsn = bsg[0];
#pragma unroll 1
                for (int tt = 0; tt < 8; ++tt) {
                    bf16x8 Wc[4];
#pragma unroll
                    for (int ks = 0; ks < 4; ++ks) Wc[ks] = Wn[ks];
                    const u32x4 Uc = Un, Zc = Zn; const float bs = bsn; const int tn = tt < 7 ? tt + 1 : 7;
#pragma unroll
                    for (int ks = 0; ks < 4; ++ks) Wn[ks] = *(const bf16x8*)(wg + (size_t)tn * 16 * 128 + 32 * ks);
                    Un = *(const u32x4*)(hbase + (size_t)tn * 16 * NIN + C_U); Zn = *(const u32x4*)(hbase + (size_t)tn * 16 * NIN + C_ZG); bsn = bsg[tn * 16];
                    f32x4 acc0 = (f32x4){0.f, 0.f, 0.f, 0.f}, acc1 = acc0;
#pragma unroll
                    for (int ks = 0; ks < 4; ++ks) { acc0 = MFMA16(Vn[ks][0], Wc[ks], acc0); acc1 = MFMA16(Vn[ks][1], Wc[ks], acc1); }
                    *(u32x4*)(ybase + (size_t)tt * 16 * DM) = pack8(bf4_lo(Uc) * (acc0 + bs) * bf4_lo(Zc), bf4_hi(Uc) * (acc1 + bs) * bf4_hi(Zc));
                }
            }
        }
        __syncthreads();
    }
}

__device__ __forceinline__ void ln_phase(float* R, bf16_t* XB, const float* g, const float* b, int G, int vcu, bool write_bf) {
    int tid_ = threadIdx.x; asm volatile("" : "+v"(tid_));
    const int tid = tid_, wid = tid >> 6, lane = tid & 63;
    f32x4 gv[4], bv[4];
#pragma unroll
    for (int j = 0; j < 4; ++j) { gv[j] = ((const f32x4*)g)[lane + 64 * j]; bv[j] = ((const f32x4*)b)[lane + 64 * j]; }
    for (int m = vcu * 8 + wid; m < MROWS; m += G * 8) {
        f32x4* xr = (f32x4*)(R + (size_t)m * DM) + lane;
        f32x4 v[4]; float s = 0.f;
#pragma unroll
        for (int j = 0; j < 4; ++j) { v[j] = xr[64 * j]; s += (v[j][0] + v[j][1]) + (v[j][2] + v[j][3]); }
        const float mean = wave_sum(s, lane) * (1.f / DM); float s2 = 0.f;
#pragma unroll
        for (int j = 0; j < 4; ++j) { v[j] = v[j] - mean; s2 += (v[j][0] * v[j][0] + v[j][1] * v[j][1]) + (v[j][2] * v[j][2] + v[j][3] * v[j][3]); }
        const float rstd = rsqrtf(wave_sum(s2, lane) * (1.f / DM) + LN_EPS);
        u32x2* o8 = (u32x2*)(XB + (size_t)m * DM) + lane;
#pragma unroll
        for (int j = 0; j < 4; ++j) { const f32x4 y = v[j] * rstd * gv[j] + bv[j]; xr[64 * j] = y;
            if (write_bf) { u32x2 w; w.x = cvt_pk_bf16(y[0], y[1]); w.y = cvt_pk_bf16(y[2], y[3]); o8[64 * j] = w; } }
    }
}

#define XB_TMO      128
#define XB_XCNT(j)  (256  + 64 * (j))
#define XB_XSUB(j)  (1280 + 64 * (j))
#define XB_XGEN(j)  (2304 + 64 * (j))
#define XB_TOP      3328
#define XB_TOPGEN   3392
#define XCD_BAR_WORDS 3456
#define XB_SPIN_CAP (1u << 18)
__device__ __forceinline__ unsigned xb_ld(unsigned* p)              { return __hip_atomic_load(p, __ATOMIC_RELAXED, __HIP_MEMORY_SCOPE_AGENT); }
__device__ __forceinline__ unsigned xb_add(unsigned* p, unsigned v) { return __hip_atomic_fetch_add(p, v, __ATOMIC_RELAXED, __HIP_MEMORY_SCOPE_AGENT); }
__device__ __forceinline__ unsigned xb_xcc_id() { return (unsigned)__builtin_amdgcn_s_getreg((3 << 11) | 20) & 0xFu; }
#define XB_SPIN(cond, bar) do { unsigned _sp = 0; while (cond) { __builtin_amdgcn_s_sleep(1); \
    if ((++_sp & 255u) == 0u) { if (xb_ld(&(bar)[XB_TMO])) break; if (_sp > XB_SPIN_CAP) { atomicAdd(&(bar)[XB_TMO], 1u); break; } } } } while (0)
struct XcdBarrier { unsigned* bar; unsigned x; volatile LAS unsigned* st; };
__device__ __forceinline__ XcdBarrier xcd_barrier_post(unsigned* bar, volatile LAS unsigned* st) {
    XcdBarrier b; b.bar = bar; b.x = xb_xcc_id(); b.st = st;
    if (threadIdx.x == 0) (void)xb_add(&bar[XB_XCNT(b.x)], 1u);
    return b;
}
__device__ __forceinline__ void xcd_barrier_complete(unsigned* bar, unsigned x, unsigned& nloc, unsigned& nx) {
    const unsigned G = gridDim.x * gridDim.y * gridDim.z;
    unsigned sum, cnt, mine, sp = 0u;
    for (;;) {
        sum = 0u; cnt = 0u; mine = 0u;
#pragma unroll
        for (unsigned j = 0; j < 16; ++j) { const unsigned c = xb_ld(&bar[XB_XCNT(j)]); sum += c; cnt += (c > 0u) ? 1u : 0u; mine = (j == x) ? c : mine; }
        if (sum == G) break;
        __builtin_amdgcn_s_sleep(1);
        if ((++sp & 255u) == 0u) { if (xb_ld(&bar[XB_TMO])) break; if (sp > XB_SPIN_CAP) { atomicAdd(&bar[XB_TMO], 1u); break; } }
    }
    nloc = mine > 0u ? mine : 1u; nx = cnt > 0u ? cnt : 1u;
}
__device__ __forceinline__ void xcd_barrier(const XcdBarrier& b) {
    asm volatile("s_waitcnt vmcnt(0)" ::: "memory");
    __syncthreads();
    if (threadIdx.x == 0) {
        unsigned* bar = b.bar;
        __builtin_amdgcn_s_waitcnt(0);
        unsigned nloc = b.st[0], nx = b.st[1];
        if (nloc == 0u) { xcd_barrier_complete(bar, b.x, nloc, nx); b.st[0] = nloc; b.st[1] = nx; }
        const unsigned old = xb_add(&bar[XB_XSUB(b.x)], 1u);
        const unsigned gen = old / nloc;
        if (old + 1u == (gen + 1u) * nloc) {
            __builtin_amdgcn_fence(__ATOMIC_RELEASE, "agent");
            asm volatile("s_waitcnt vmcnt(0)" ::: "memory");
            const unsigned og = xb_add(&bar[XB_TOP], 1u);
            const unsigned tg = og / nx;
            if (og + 1u == (tg + 1u) * nx) xb_add(&bar[XB_TOPGEN], 1u);
            else XB_SPIN(xb_ld(&bar[XB_TOPGEN]) == tg, bar);
            __builtin_amdgcn_fence(__ATOMIC_ACQUIRE, "agent");
            xb_add(&bar[XB_XGEN(b.x)], 1u);
            asm volatile("s_waitcnt vmcnt(0)" ::: "memory");
        } else {
            XB_SPIN(xb_ld(&bar[XB_XGEN(b.x)]) == gen, bar);
            __builtin_amdgcn_fence(__ATOMIC_ACQUIRE, "agent");
            asm volatile("s_waitcnt vmcnt(0)" ::: "memory");
        }
    }
    __syncthreads();
}
#define grid_barrier(g) xcd_barrier(xbar)

__global__ void __launch_bounds__(512, 2) fwd_megakernel(Params p) {
    extern __shared__ __attribute__((aligned(16))) unsigned char lds_raw[];
    LAS unsigned char* lds = (LAS unsigned char*)lds_raw;
    cg::grid_group grid = cg::this_grid();
    const int G = gridDim.x, bx = blockIdx.x;
    const int vcu = (G % 8 == 0) ? (bx % 8) * (G / 8) + bx / 8 : bx;

    volatile LAS unsigned* xst = (volatile LAS unsigned*)(lds + LDS_BYTES - 64);
    if (threadIdx.x < 2) xst[threadIdx.x] = 0u;
    __syncthreads();
    XcdBarrier xbar = xcd_barrier_post((unsigned*)(p.ws + WS_CTL), xst);
    grid.sync();
    prologue_phase(p, lds, G, vcu);
    grid_barrier(grid);
#pragma unroll 1
    for (int l = 0; l < DEPTH; ++l) {
        unsigned char* ws = p.ws; asm volatile("" : "+s"(ws));
        bf16_t* WIN = (bf16_t*)(ws + WS_WIN); bf16_t* WBR = (bf16_t*)(ws + WS_WBR); bf16_t* WOUT = (bf16_t*)(ws + WS_WOUT); bf16_t* WSP = (bf16_t*)(ws + WS_WSP);
        bf16_t* XB = (bf16_t*)(ws + WS_XB); bf16_t* Y = (bf16_t*)(ws + WS_Y); bf16_t* H = (bf16_t*)(ws + WS_H);
        {
            pg8::Gemm g{XB, WIN + (size_t)l * NIN * DM, DM, DM, DM}; pg8::Order S; S.init(MROWS, NIN, G, bx, 1);
            pg8::EpiH E{H, p.in[2] + (size_t)l * NIN};
            pg8::gemm_phase<pg8::EpiH>(lds, g, S, E);
        }
        grid_barrier(grid);
        mixer_phase(lds, H, Y, WSP + (size_t)l * 4 * 128 * 128, p.in[3] + l * 8, p.in[4] + l * 512, p.in[5] + l * 512, p.in[7] + l * 512, G, vcu);
        grid_barrier(grid);
        {
            pg8::Gemm g{Y, WBR + (size_t)l * DM * DM, 512, DM, DM}; pg8::Order S; S.init(MROWS, DM, G, bx, 2);
            pg8::EpiMerge E{H};
            pg8::gemm_phase<pg8::EpiMerge>(lds, g, S, E);
        }
        grid_barrier(grid);
        {
            pg8::Gemm g{H, WOUT + (size_t)l * DM * DM, DM, NIN, DM}; pg8::Order S; S.init(MROWS, DM, G, bx, 1);
            pg8::EpiRes E{l == 0 ? p.in[0] : (const float*)p.out, p.out, p.in[11] + (size_t)l * DM};
            pg8::gemm_phase<pg8::EpiRes>(lds, g, S, E);
        }
        grid_barrier(grid);
        ln_phase(p.out, XB, p.in[12] + (size_t)l * DM, p.in[13] + (size_t)l * DM, G, vcu, l + 1 < DEPTH);
        if (l + 1 < DEPTH) grid_barrier(grid);
    }
}

extern "C" void kernel_launch(void* const* d_in, const int* in_sizes, int n_in, void* d_out, int out_size, void* d_ws, size_t ws_size, hipStream_t stream) {
    static int grid_blocks = 0;
    if (grid_blocks == 0) {
        if (n_in != 14 || out_size != MROWS * DM || ws_size < WS_END) { fprintf(stderr, "kernel_launch: unexpected shapes (n_in %d out %d ws %zu)\n", n_in, out_size, ws_size); grid_blocks = -1; return; }
        int dev = 0, cus = 0, per_cu = 0;
        hipGetDevice(&dev);
        hipDeviceGetAttribute(&cus, hipDeviceAttributeMultiprocessorCount, dev);
        hipFuncSetAttribute((const void*)fwd_megakernel, hipFuncAttributeMaxDynamicSharedMemorySize, LDS_BYTES);
        hipOccupancyMaxActiveBlocksPerMultiprocessor(&per_cu, (const void*)fwd_megakernel, 512, LDS_BYTES);
        if (per_cu < 1) { fprintf(stderr, "kernel_launch: occupancy query says %d blocks/CU\n", per_cu); per_cu = 1; }
        grid_blocks = cus * per_cu;
    }
    if (grid_blocks < 0) return;
    if (hipMemsetAsync((char*)d_ws + WS_CTL, 0, 16384, stream) != hipSuccess) { fprintf(stderr, "kernel_launch: memset failed\n"); return; }
    Params p{};
    for (int i = 0; i < 14; ++i) p.in[i] = (const float*)d_in[i];
    p.out = (float*)d_out; p.ws = (unsigned char*)d_ws;
    void* args[] = {&p};
    hipError_t e = hipLaunchCooperativeKernel((const void*)fwd_megakernel, dim3(grid_blocks), dim3(512), args, LDS_BYTES, stream);
    if (e != hipSuccess) fprintf(stderr, "cooperative launch failed: %s (grid %d)\n", hipGetErrorString(e), grid_blocks);
}
```
